# Optimizing an MI355X kernel written in HIP

```python
import jax, jax.numpy as jnp
from jax import lax
import numpy as np

D_MODEL = 1024
BATCH = 4
SEQ = 8192
DEPTH = 4

N_MIXERS = 3
EPS = 1e-6

RET_HEADS = 4
RET_QK_DIM = D_MODEL // RET_HEADS
RET_V_DIM = 2 * RET_QK_DIM
RET_CHUNK = 128
RET_ROPE_BASE = 10000.0
RET_IN = 2 * RET_HEADS * RET_QK_DIM + 2 * RET_HEADS * RET_V_DIM

GM_CHUNK = 128
GM_FFN = 6 * D_MODEL
GM_HALF = GM_FFN // 2
GM_GROUPS = 4
GM_GROUP_DIM = GM_HALF // GM_GROUPS

GRID_W = 64
NA_HEADS = 32
NA_HEAD_DIM = D_MODEL // NA_HEADS
NA_WIN_ROWS = 8
NA_WIN_COLS = 16

N_GROUPS = 4
EXPERTS_PER_GROUP = 4
N_EXPERTS = N_GROUPS * EXPERTS_PER_GROUP
TOP_K = 2
D_EXPERT = 512

kernel_name = 'hybrid_retention_gmlp_natten_grouped_moe_encoder'


def _rmsnorm(x, g):
    xf = x.astype(jnp.float32)
    y = xf * lax.rsqrt(jnp.mean(xf * xf, axis=-1, keepdims=True) + EPS)
    return (y * g.astype(jnp.float32)).astype(x.dtype)


def _layernorm(x, g, b):
    xf = x.astype(jnp.float32)
    mu = jnp.mean(xf, axis=-1, keepdims=True)
    var = jnp.mean(jnp.square(xf - mu), axis=-1, keepdims=True)
    y = (xf - mu) * lax.rsqrt(var + EPS)
    return (y * g.astype(jnp.float32) + b.astype(jnp.float32)).astype(x.dtype)


def _rotary(x, pos):
    half = x.shape[-1] // 2
    inv_freq = RET_ROPE_BASE ** (-jnp.arange(half, dtype=jnp.float32) / half)
    ang = pos[:, None] * inv_freq[None, :]
    cos = jnp.cos(ang)[None, :, None, :].astype(x.dtype)
    sin = jnp.sin(ang)[None, :, None, :].astype(x.dtype)
    x1, x2 = x[..., :half], x[..., half:]
    return jnp.concatenate([x1 * cos - x2 * sin, x1 * sin + x2 * cos], axis=-1)


def _retention_causal(q, k, v, log_gamma, include_diag):
    bsz, nh, seq, dk = q.shape
    dv = v.shape[-1]
    n_chunks = seq // RET_CHUNK
    qc = q.reshape(bsz, nh, n_chunks, RET_CHUNK, dk)
    kc = k.reshape(bsz, nh, n_chunks, RET_CHUNK, dk)
    vc = v.reshape(bsz, nh, n_chunks, RET_CHUNK, dv)
    idx = jnp.arange(RET_CHUNK, dtype=jnp.float32)
    diff = idx[:, None] - idx[None, :]
    mask = (diff >= 0) if include_diag else (diff > 0)
    decay = jnp.where(mask[None], jnp.exp(log_gamma[:, None, None] * jnp.where(mask, diff, 0.0)[None]), 0.0)
    scores = jnp.einsum('bhncd,bhnmd->bhncm', qc, kc) * decay[None, :, None]
    inner = jnp.einsum('bhncm,bhnme->bhnce', scores, vc)
    xi = jnp.exp(log_gamma[:, None] * (idx[None, :] + 1.0))
    zeta = jnp.exp(log_gamma[:, None] * (RET_CHUNK - 1.0 - idx[None, :]))
    chunk_decay = jnp.exp(log_gamma * RET_CHUNK)

    def step(state, inp):
        q_i, k_i, v_i = inp
        cross = jnp.einsum('bhcd,bhde->bhce', q_i, state) * xi[None, :, :, None]
        state = state * chunk_decay[None, :, None, None] + jnp.einsum(
            'bhcd,bhce->bhde', k_i, v_i * zeta[None, :, :, None])
        return state, cross

    state0 = jnp.zeros((bsz, nh, dk, dv), jnp.float32)
    _, cross = lax.scan(step, state0, (jnp.moveaxis(qc, 2, 0), jnp.moveaxis(kc, 2, 0), jnp.moveaxis(vc, 2, 0)))
    out = inner + jnp.moveaxis(cross, 0, 2)
    return out.reshape(bsz, nh, seq, dv)


def _retention_mixer(h, w_in, decay_logit, w_out):
    bsz, seq, _ = h.shape
    nq = RET_HEADS * RET_QK_DIM
    nv = RET_HEADS * RET_V_DIM
    proj = h @ w_in
    q = proj[..., :nq].reshape(bsz, seq, RET_HEADS, RET_QK_DIM)
    k = proj[..., nq:2 * nq].reshape(bsz, seq, RET_HEADS, RET_QK_DIM)
    v = proj[..., 2 * nq:2 * nq + nv].reshape(bsz, seq, RET_HEADS, RET_V_DIM)
    gate = proj[..., 2 * nq + nv:]
    pos = jnp.arange(seq, dtype=jnp.float32)
    q = _rotary(q, pos)
    k = _rotary(k, pos) * (RET_QK_DIM ** -0.5)
    q, k, v = (jnp.swapaxes(t, 1, 2) for t in (q, k, v))
    log_gamma = jax.nn.log_sigmoid(decay_logit.astype(jnp.float32))
    fwd = _retention_causal(q, k, v, log_gamma[0], True)
    bwd = jnp.flip(_retention_causal(jnp.flip(q, 2), jnp.flip(k, 2), jnp.flip(v, 2), log_gamma[1], False), 2)
    o = (fwd + bwd).astype(jnp.float32)
    o = o * lax.rsqrt(jnp.mean(o * o, axis=-1, keepdims=True) + EPS)
    o = jnp.swapaxes(o, 1, 2).reshape(bsz, seq, nv).astype(h.dtype)
    return (jax.nn.silu(gate) * o) @ w_out


def _gmlp_mixer(h, w_in, ln_g, ln_b, w_s, b_s, w_out):
    bsz, seq, _ = h.shape
    n_chunks = seq // GM_CHUNK
    z = jax.nn.gelu(h @ w_in, approximate=False)
    u, v = z[..., :GM_HALF], z[..., GM_HALF:]
    v = _layernorm(v, ln_g, ln_b).reshape(bsz, n_chunks, GM_CHUNK, GM_GROUPS, GM_GROUP_DIM)
    mixed = jnp.einsum('gts,bnsgc->bntgc', w_s, v) + jnp.swapaxes(b_s, 0, 1)[None, None, :, :, None]
    return (u * mixed.reshape(bsz, seq, GM_HALF)) @ w_out


def _neighbourhood_mixer(h, w_qkv, rpb, w_out):
    bsz, seq, _ = h.shape
    rows = seq // GRID_W
    kr = min(NA_WIN_ROWS, rows)
    kc = NA_WIN_COLS
    qkv = (h @ w_qkv).reshape(bsz, rows, GRID_W, 3, NA_HEADS, NA_HEAD_DIM)
    q = qkv[:, :, :, 0] * (NA_HEAD_DIM ** -0.5)
    k = qkv[:, :, :, 1]
    v = qkv[:, :, :, 2]
    col = jnp.arange(GRID_W)
    col_idx = jnp.clip(col - kc // 2, 0, GRID_W - kc)[:, None] + jnp.arange(kc)[None, :]
    rpb_cols = rpb[:, :, col_idx - col[:, None] + kc - 1]

    def row_block(args):
        r, q_row = args
        r0 = jnp.clip(r - kr // 2, 0, rows - kr)
        k_win = lax.dynamic_slice_in_dim(k, r0, kr, axis=1)[:, :, col_idx]
        v_win = lax.dynamic_slice_in_dim(v, r0, kr, axis=1)[:, :, col_idx]
        row_off = r0 + jnp.arange(kr) - r + NA_WIN_ROWS - 1
        bias = jnp.transpose(rpb_cols[:, row_off], (0, 2, 1, 3)).astype(jnp.float32)
        s = jnp.einsum('bqhd,brqchd->bhqrc', q_row, k_win).astype(jnp.float32) + bias[None]
        p = jax.nn.softmax(s.reshape(bsz, NA_HEADS, GRID_W, kr * kc), axis=-1)
        p = p.reshape(bsz, NA_HEADS, GRID_W, kr, kc).astype(v.dtype)
        return jnp.einsum('bhqrc,brqchd->bqhd', p, v_win)

    out = lax.map(row_block, (jnp.arange(rows, dtype=jnp.int32), jnp.moveaxis(q, 1, 0)))
    out = jnp.moveaxis(out, 0, 1).reshape(bsz, seq, D_MODEL)
    return out @ w_out


def _grouped_moe(h, router_w, router_b, w_gate_up, w_down):
    bsz, seq, d = h.shape
    t = h.reshape(bsz * seq, d)
    scores = jax.nn.sigmoid((t @ router_w).astype(jnp.float32))
    biased = scores + router_b.astype(jnp.float32)
    grp_top = lax.top_k(biased.reshape(-1, N_GROUPS, EXPERTS_PER_GROUP), TOP_K)[0]
    grp_sel = jnp.argmax(jnp.sum(grp_top, axis=-1), axis=-1)
    in_grp = (jnp.arange(N_EXPERTS) // EXPERTS_PER_GROUP)[None, :] == grp_sel[:, None]
    _, top_idx = lax.top_k(jnp.where(in_grp, biased, -jnp.inf), TOP_K)
    sel = jnp.take_along_axis(scores, top_idx, axis=-1)
    w = sel / jnp.sum(sel, axis=-1, keepdims=True)
    gates = jnp.sum(jax.nn.one_hot(top_idx, N_EXPERTS, dtype=jnp.float32) * w[..., None], axis=1).astype(t.dtype)
    y = jnp.zeros_like(t)
    for e in range(N_EXPERTS):
        gu = t @ w_gate_up[e]
        hid = jax.nn.silu(gu[:, :D_EXPERT]) * gu[:, D_EXPERT:]
        y = y + gates[:, e:e + 1] * (hid @ w_down[e])
    return y.reshape(bsz, seq, d)


def setup_inputs(seed: int = 0) -> dict:
    key = jax.random.key(seed)
    ks = jax.random.split(key, 24)
    f32 = jnp.float32
    n_ret = len(range(0, DEPTH, N_MIXERS))
    n_gm = len(range(1, DEPTH, N_MIXERS))
    n_na = len(range(2, DEPTH, N_MIXERS))

    def nrm(k, shape, scale):
        return jax.random.normal(k, shape, f32) * scale

    base_logit = np.log(2.0 ** (5.0 + np.arange(RET_HEADS)) - 1.0).astype(np.float32)
    return {
        'x': nrm(ks[0], (BATCH, SEQ, D_MODEL), 1.0),
        'c': nrm(ks[1], (BATCH, D_MODEL), 1.0),
        'norm_g': 1.0 + nrm(ks[2], (DEPTH, 2, D_MODEL), 0.02),
        'final_g': 1.0 + nrm(ks[3], (D_MODEL,), 0.02),
        'w_ada': nrm(ks[4], (DEPTH, D_MODEL, 6 * D_MODEL), 0.5 * D_MODEL ** -0.5),
        'b_ada': nrm(ks[5], (DEPTH, 6 * D_MODEL), 0.02),
        'ret_w_in': nrm(ks[6], (n_ret, D_MODEL, RET_IN), D_MODEL ** -0.5),
        'ret_decay_logit': jnp.asarray(base_logit)[None, None, :] + nrm(ks[7], (n_ret, 2, RET_HEADS), 0.1),
        'ret_w_out': nrm(ks[8], (n_ret, RET_HEADS * RET_V_DIM, D_MODEL), (RET_HEADS * RET_V_DIM) ** -0.5),
        'gm_w_in': nrm(ks[9], (n_gm, D_MODEL, GM_FFN), D_MODEL ** -0.5),
        'gm_ln_g': 1.0 + nrm(ks[10], (n_gm, GM_HALF), 0.02),
        'gm_ln_b': nrm(ks[11], (n_gm, GM_HALF), 0.02),
        'gm_w_s': nrm(ks[12], (n_gm, GM_GROUPS, GM_CHUNK, GM_CHUNK), GM_CHUNK ** -0.5),
        'gm_b_s': 1.0 + nrm(ks[13], (n_gm, GM_GROUPS, GM_CHUNK), 0.1),
        'gm_w_out': nrm(ks[14], (n_gm, GM_HALF, D_MODEL), GM_HALF ** -0.5),
        'na_w_qkv': nrm(ks[15], (n_na, D_MODEL, 3 * D_MODEL), D_MODEL ** -0.5),
        'na_rpb': nrm(ks[16], (n_na, NA_HEADS, 2 * NA_WIN_ROWS - 1, 2 * NA_WIN_COLS - 1), 0.05),
        'na_w_out': nrm(ks[17], (n_na, D_MODEL, D_MODEL), D_MODEL ** -0.5),
        'router_w': nrm(ks[18], (D_MODEL, N_EXPERTS), D_MODEL ** -0.5),
        'router_b': nrm(ks[19], (N_EXPERTS,), 0.01),
        'moe_w_gate_up': nrm(ks[20], (DEPTH, N_EXPERTS, D_MODEL, 2 * D_EXPERT), D_MODEL ** -0.5),
        'moe_w_down': nrm(ks[21], (DEPTH, N_EXPERTS, D_EXPERT, D_MODEL), D_EXPERT ** -0.5),
    }


def reference(x, c, norm_g, final_g, w_ada, b_ada, ret_w_in, ret_decay_logit, ret_w_out,
              gm_w_in, gm_ln_g, gm_ln_b, gm_w_s, gm_b_s, gm_w_out, na_w_qkv, na_rpb, na_w_out,
              router_w, router_b, moe_w_gate_up, moe_w_down):
    c_act = jax.nn.silu(c)
    for i in range(DEPTH):
        kind, j = i % N_MIXERS, i // N_MIXERS
        mod = c_act @ w_ada[i] + b_ada[i]
        sh1, sc1, g1, sh2, sc2, g2 = [m[:, None, :] for m in jnp.split(mod, 6, axis=-1)]
        h = _rmsnorm(x, norm_g[i, 0]) * (1 + sc1) + sh1
        if kind == 0:
            y = _retention_mixer(h, ret_w_in[j], ret_decay_logit[j], ret_w_out[j])
        elif kind == 1:
            y = _gmlp_mixer(h, gm_w_in[j], gm_ln_g[j], gm_ln_b[j], gm_w_s[j], gm_b_s[j], gm_w_out[j])
        else:
            y = _neighbourhood_mixer(h, na_w_qkv[j], na_rpb[j], na_w_out[j])
        x = x + g1 * y
        h = _rmsnorm(x, norm_g[i, 1]) * (1 + sc2) + sh2
        x = x + g2 * _grouped_moe(h, router_w, router_b, moe_w_gate_up[i], moe_w_down[i])
    return _rmsnorm(x, final_g)
```

```cpp
#include <hip/hip_runtime.h>
#include <cstdio>
#include <cstdint>

#define LAS __attribute__((address_space(3)))
#define GAS __attribute__((address_space(1)))
typedef unsigned short bf16_t;
typedef short bf16x8 __attribute__((ext_vector_type(8)));
typedef short s16x4 __attribute__((ext_vector_type(4)));
typedef float f32x4 __attribute__((ext_vector_type(4)));
typedef float f32x2 __attribute__((ext_vector_type(2)));
typedef float f32x16 __attribute__((ext_vector_type(16)));
typedef unsigned u32x4 __attribute__((ext_vector_type(4)));
typedef unsigned u32x2 __attribute__((ext_vector_type(2)));

constexpr int NB = 4, SEQ = 8192, T = NB * SEQ, D = 1024, DEPTH = 4;
constexpr int RET_IN = 6144, GM_FFN = 6144, GM_HALF = 3072;
constexpr int NCLS = 24;
constexpr int MOE_ROWS = T + NCLS * 256;
constexpr float EPS = 1e-6f;
constexpr float LOG2E = 1.4426950408889634f;

typedef __bf16 bf16x2_t __attribute__((ext_vector_type(2)));
__device__ __forceinline__ unsigned cvt_pk_bf16(float lo, float hi) { const f32x2 v = {lo, hi}; const bf16x2_t b = __builtin_convertvector(v, bf16x2_t); return __builtin_bit_cast(unsigned, b); }
__device__ __forceinline__ float bf_lo(unsigned w) { return __uint_as_float(w << 16); }
__device__ __forceinline__ float bf_hi(unsigned w) { return __uint_as_float(w & 0xffff0000u); }
__device__ __forceinline__ float fast_exp2(float x) { return __builtin_amdgcn_exp2f(x); }
__device__ __forceinline__ float fast_rcp(float x) { return __builtin_amdgcn_rcpf(x); }
__device__ __forceinline__ float silu_f(float x) { return x * fast_rcp(1.0f + fast_exp2(-x * LOG2E)); }

namespace pg8 {
constexpr int BM = 256, BK = 64, HALF = 128, HTB = HALF * BK * 2, STAGE_BYTES = 8 * HTB, NXCD = 8, WGM = 8;
__host__ __device__ __forceinline__ int lds_byte(int r, int c) { const int st = (r >> 4) * 2 + (c >> 5), rr = r & 15, cc = c & 31, ob = rr * 64 + cc * 2; return st * 1024 + (ob ^ (((ob >> 9) & 1) << 5)); }
__host__ __device__ __forceinline__ void stage_rc(int b, int& R, int& C) { const int st = b / 1024, sb = b % 1024, swz = sb ^ (((sb >> 9) & 1) << 5); R = (st >> 1) * 16 + swz / 64; C = (st & 1) * 32 + (swz % 64) / 2; }
__host__ __device__ __forceinline__ int perm32(int rho) { const int n = rho >> 4, i = rho & 15; return 8 * (i >> 2) + 4 * n + (i & 3); }

struct Unit { int pm, pn; const char* A; const char* B; const char* B2; int aux; };

struct DenseOrder {
    int nM, nN, nwg, G, c; const char* Abase; const char* Bbase; size_t atile, btile;
    __device__ void init(int M, int N, int G_, int c_, const void* A, size_t lda, const void* Bt, size_t ldb) { nM = M / BM; nN = N / BM; nwg = nM * nN; G = G_; c = c_; Abase = (const char*)A; Bbase = (const char*)Bt; atile = (size_t)BM * lda * 2; btile = (size_t)BM * ldb * 2; }
    __device__ bool next(int i, Unit& u) const {
        const long L = (long)i * G + c; if (L >= nwg) return false;
        int wgid = (int)L; { const int q = nwg / NXCD, r = nwg % NXCD, xcd = wgid % NXCD, off = wgid / NXCD; wgid = (xcd < r ? xcd * (q + 1) : r * (q + 1) + (xcd - r) * q) + off; }
        const int nig = WGM * nN, gid = wgid / nig, fm = gid * WGM, gsz = (nM - fm) < WGM ? (nM - fm) : WGM;
        u.pm = fm + ((wgid % nig) % gsz); u.pn = (wgid % nig) / gsz; u.A = Abase + (size_t)u.pm * atile; u.B = Bbase + (size_t)u.pn * btile; u.B2 = u.B; u.aux = 0; return true;
    }
};

__device__ __forceinline__ f32x2 gelu_pk(f32x2 v) {
    const f32x2 av = __builtin_elementwise_abs(v), d = av * 0.2316418882f + 1.0f;
    f32x2 t; t.x = __builtin_amdgcn_rcpf(d.x); t.y = __builtin_amdgcn_rcpf(d.y);
    f32x2 q = t * 0.5307027145f + (-0.7265760135f); q = q * t + 0.7107068705f; q = q * t + (-0.142248368f); q = q * t + 0.127414796f; q = q * t;
    const f32x2 s = (v * v) * (-0.72134752044f);
    f32x2 e; e.x = __builtin_amdgcn_exp2f(s.x); e.y = __builtin_amdgcn_exp2f(s.y);
    const f32x2 m = v * (q * e), r = v - m;
    f32x2 o; o.x = v.x < 0.f ? m.x : r.x; o.y = v.y < 0.f ? m.y : r.y; return o;
}

template <class Epi, class Sched, bool ALIGN_EPI, int KSW>
__device__ __forceinline__ void gemm_phase(LAS unsigned char* lds, const int K, const int lda, const int ldb, const Sched& S, const Epi& E) {
    int tid_ = threadIdx.x; asm volatile("" : "+v"(tid_));
    const int tid = tid_, wid = __builtin_amdgcn_readfirstlane(tid >> 6), lane = tid & 63, wr = wid >> 2, wc = wid & 3, fr = lane & 15, fq = lane >> 4;
    const int nt = K / BK;
    unsigned voffA[2], voffB[2];
#pragma unroll
    for (int i = 0; i < 2; ++i) { int R, C; stage_rc(tid * 16 + i * 8192, R, C); const int Rb = Epi::PERM ? ((R & ~31) + perm32(R & 31)) : R;
        voffA[i] = (unsigned)(R * lda + C) * 2u; voffB[i] = (unsigned)(Rb * ldb + C) * 2u; }
    const size_t kstep = (size_t)(BK * 2);
    const size_t hstepA = (size_t)HALF * lda * 2, hstepB = (size_t)HALF * ldb * 2;
    const unsigned ldsw = (unsigned)wid * 1024u;
    const int aoff = lds_byte(wr * 64 + fr, fq * 8), boff = lds_byte(wc * 32 + fr, fq * 8);
#define PG8_SA(b, h) (((b) * 2 + (h)) * HTB)
#define PG8_SB(b, h) ((4 + (b) * 2 + (h)) * HTB)
#define PG8_STAGE(bufoff, gbase, voff) do { _Pragma("unroll") for (int _i = 0; _i < 2; ++_i) \
        __builtin_amdgcn_global_load_lds((const unsigned*)((const char*)(gbase) + (voff)[_i]), (LAS unsigned*)(lds + (bufoff) + ldsw + _i * 8192), 16, 0, 0); } while (0)
#define PG8_LDA(dst, b, h) do { _Pragma("unroll") for (int m = 0; m < 4; ++m) _Pragma("unroll") for (int k = 0; k < 2; ++k) dst[m][k] = *(const LAS bf16x8*)(lds + PG8_SA(b, h) + aoff + m * 2048 + k * 1024); } while (0)
#define PG8_LDB(dst, b, h) do { _Pragma("unroll") for (int n = 0; n < 2; ++n) _Pragma("unroll") for (int k = 0; k < 2; ++k) dst[n][k] = *(const LAS bf16x8*)(lds + PG8_SB(b, h) + boff + n * 2048 + k * 1024); } while (0)
#define PG8_MMA(ai, bj, At, Bt) do { __builtin_amdgcn_s_setprio(1); _Pragma("unroll") for (int m = 0; m < 4; ++m) _Pragma("unroll") for (int n = 0; n < 2; ++n) _Pragma("unroll") for (int k = 0; k < 2; ++k) \
        acc[ai][bj][m][n] = __builtin_amdgcn_mfma_f32_16x16x32_bf16(Bt[n][k], At[m][k], acc[ai][bj][m][n], 0, 0, 0); __builtin_amdgcn_s_setprio(0); } while (0)
#define PG8_WAIT_V(n) asm volatile("s_waitcnt vmcnt(" #n ")" ::: "memory")
#define PG8_WAIT_L(n) asm volatile("s_waitcnt lgkmcnt(" #n ")" ::: "memory")
#define PG8_BAR __builtin_amdgcn_s_barrier()
#define PG8_SCHED __builtin_amdgcn_sched_barrier(0)
#define PG8_BPTR(u_, t_) ((KSW > 0 && (t_) >= KSW) ? (u_).B2 + (size_t)((t_) - KSW) * kstep : (u_).B + (size_t)(t_) * kstep)
    Unit cur, nxt; int ui = 0;
    if (!S.next(0, cur)) return;
    f32x4 acc[2][2][4][2];
#pragma unroll
    for (int a = 0; a < 2; ++a)
#pragma unroll
        for (int b = 0; b < 2; ++b)
#pragma unroll
            for (int m = 0; m < 4; ++m)
#pragma unroll
                for (int n = 0; n < 2; ++n) acc[a][b][m][n] = (f32x4){0.f, 0.f, 0.f, 0.f};
    bf16x8 At[4][2], B0[2][2], B1[2][2];
    const char* cA = cur.A; const char* cB = cur.B;
    PG8_STAGE(PG8_SB(0, 0), cB, voffB); PG8_STAGE(PG8_SB(0, 1), cB + hstepB, voffB); PG8_STAGE(PG8_SA(0, 0), cA, voffA); PG8_STAGE(PG8_SA(0, 1), cA + hstepA, voffA);
    if (wr == 1) PG8_BAR;
    PG8_WAIT_V(2); PG8_BAR;
    PG8_STAGE(PG8_SB(1, 0), cB + kstep, voffB); PG8_STAGE(PG8_SA(1, 0), cA + kstep, voffA); PG8_STAGE(PG8_SB(1, 1), cB + hstepB + kstep, voffB);
    PG8_WAIT_V(6); PG8_BAR;
    for (;;) {
        const bool has_next = S.next(ui + 1, nxt);
        const char* nA = has_next ? nxt.A : cA; const char* nB = has_next ? nxt.B : cB;
        for (int t = 0; t < nt; t += 2) {
            const bool last = (t == nt - 2);
            const char* a1 = cA + (size_t)(t + 1) * kstep;
            const char* a2 = last ? nA : cA + (size_t)(t + 2) * kstep; const char* b2 = last ? nB : PG8_BPTR(cur, t + 2);
            const char* a3 = a2 + kstep; const char* b3 = last ? nB + kstep : PG8_BPTR(cur, t + 3);
            PG8_LDB(B0, 0, 0); PG8_LDB(B1, 0, 1); PG8_SCHED; PG8_LDA(At, 0, 0); PG8_STAGE(PG8_SA(1, 1), a1 + hstepA, voffA);
            PG8_WAIT_V(8); PG8_WAIT_L(0); PG8_BAR; PG8_MMA(0, 0, At, B0); PG8_MMA(0, 1, At, B1); PG8_BAR; PG8_SCHED;
            PG8_LDA(At, 0, 1); PG8_STAGE(PG8_SB(0, 0), b2, voffB); PG8_STAGE(PG8_SB(0, 1), b2 + hstepB, voffB); PG8_STAGE(PG8_SA(0, 0), a2, voffA);
            PG8_WAIT_V(8); PG8_WAIT_L(0); PG8_BAR; PG8_MMA(1, 0, At, B0); PG8_MMA(1, 1, At, B1); PG8_BAR; PG8_SCHED;
            PG8_LDB(B0, 1, 0); PG8_LDB(B1, 1, 1); PG8_SCHED; PG8_LDA(At, 1, 0); PG8_STAGE(PG8_SA(0, 1), a2 + hstepA, voffA);
            PG8_WAIT_V(8); PG8_WAIT_L(0); PG8_BAR; PG8_MMA(0, 0, At, B0); PG8_MMA(0, 1, At, B1); PG8_BAR; PG8_SCHED;
            PG8_LDA(At, 1, 1); PG8_STAGE(PG8_SB(1, 0), b3, voffB); PG8_STAGE(PG8_SB(1, 1), b3 + hstepB, voffB); PG8_STAGE(PG8_SA(1, 0), a3, voffA);
            PG8_WAIT_V(8); PG8_WAIT_L(0); PG8_BAR; PG8_MMA(1, 0, At, B0); PG8_MMA(1, 1, At, B1); PG8_BAR; PG8_SCHED;
        }
        if constexpr (ALIGN_EPI) { if (wr == 0) PG8_BAR; }
        E(acc, cur, wr, wc, fr, fq);
        if (!has_next) break;
#pragma unroll
        for (int a = 0; a < 2; ++a)
#pragma unroll
            for (int b = 0; b < 2; ++b)
#pragma unroll
                for (int m = 0; m < 4; ++m)
#pragma unroll
                    for (int n = 0; n < 2; ++n) acc[a][b][m][n] = (f32x4){0.f, 0.f, 0.f, 0.f};
        cur = nxt; cA = nA; cB = nB; ++ui;
        if constexpr (ALIGN_EPI) { if (wr == 1) PG8_BAR; }
    }
    PG8_WAIT_V(0);
    if constexpr (!ALIGN_EPI) { if (wr == 0) PG8_BAR; }
    PG8_BAR;
#undef PG8_SA
#undef PG8_SB
#undef PG8_STAGE
#undef PG8_LDA
#undef PG8_LDB
#undef PG8_MMA
#undef PG8_WAIT_V
#undef PG8_WAIT_L
#undef PG8_BAR
#undef PG8_SCHED
#undef PG8_BPTR
}
}

#define XB_TMO      128
#define XB_XCNT(j)  (256  + 64 * (j))
#define XB_XSUB(j)  (1280 + 64 * (j))
#define XB_XGEN(j)  (2304 + 64 * (j))
#define XB_TOP      3328
#define XB_TOPGEN   3392
#define XCD_BAR_WORDS 3456
#define XB_SPIN_CAP (1u << 22)

__device__ __forceinline__ unsigned xb_ld(unsigned* p)              { return __hip_atomic_load(p, __ATOMIC_RELAXED, __HIP_MEMORY_SCOPE_AGENT); }
__device__ __forceinline__ unsigned xb_add(unsigned* p, unsigned v) { return __hip_atomic_fetch_add(p, v, __ATOMIC_RELAXED, __HIP_MEMORY_SCOPE_AGENT); }
__device__ __forceinline__ unsigned xb_xcc_id() { return (unsigned)__builtin_amdgcn_s_getreg((3 << 11) | 20) & 0xFu; }
#define XB_SPIN(cond, bar) do { unsigned _sp = 0; while (cond) { __builtin_amdgcn_s_sleep(1); \
    if ((++_sp & 255u) == 0u) { if (xb_ld(&(bar)[XB_TMO])) break; if (_sp > XB_SPIN_CAP) { atomicAdd(&(bar)[XB_TMO], 1u); break; } } } } while (0)

struct XcdBarrier { unsigned* bar; unsigned x; volatile LAS unsigned* st; };

__device__ __forceinline__ XcdBarrier xcd_barrier_post(unsigned* bar, volatile LAS unsigned* st) {
    XcdBarrier b; b.bar = bar; b.x = xb_xcc_id(); b.st = st;
    if (threadIdx.x == 0) (void)xb_add(&bar[XB_XCNT(b.x)], 1u);
    return b;
}
__device__ __forceinline__ void xcd_barrier_complete(unsigned* bar, unsigned x, unsigned& nloc, unsigned& nx) {
    const unsigned G = gridDim.x * gridDim.y * gridDim.z;
    unsigned sum, cnt, mine, sp = 0u;
    for (;;) {
        sum = 0u; cnt = 0u; mine = 0u;
#pragma unroll
        for (unsigned j = 0; j < 16; ++j) { const unsigned c = xb_ld(&bar[XB_XCNT(j)]); sum += c; cnt += (c > 0u) ? 1u : 0u; mine = (j == x) ? c : mine; }
        if (sum == G) break;
        __builtin_amdgcn_s_sleep(1);
        if ((++sp & 255u) == 0u) { if (xb_ld(&bar[XB_TMO])) break; if (sp > XB_SPIN_CAP) { atomicAdd(&bar[XB_TMO], 1u); break; } }
    }
    nloc = mine > 0u ? mine : 1u; nx = cnt > 0u ? cnt : 1u;
}
__device__ __forceinline__ void xcd_barrier(const XcdBarrier& b) {
    asm volatile("s_waitcnt vmcnt(0)" ::: "memory");
    __syncthreads();
    if (threadIdx.x == 0) {
        unsigned* bar = b.bar;
        __builtin_amdgcn_s_waitcnt(0);
        unsigned nloc = b.st[0], nx = b.st[1];
        if (nloc == 0u) { xcd_barrier_complete(bar, b.x, nloc, nx); b.st[0] = nloc; b.st[1] = nx; }
        const unsigned old = xb_add(&bar[XB_XSUB(b.x)], 1u);
        const unsigned gen = old / nloc;
        if (old + 1u == (gen + 1u) * nloc) {
            __builtin_amdgcn_fence(__ATOMIC_RELEASE, "agent");
            asm volatile("s_waitcnt vmcnt(0)" ::: "memory");
            const unsigned og = xb_add(&bar[XB_TOP], 1u);
            const unsigned tg = og / nx;
            if (og + 1u == (tg + 1u) * nx) xb_add(&bar[XB_TOPGEN], 1u);
            else XB_SPIN(xb_ld(&bar[XB_TOPGEN]) == tg, bar);
            __builtin_amdgcn_fence(__ATOMIC_ACQUIRE, "agent");
            xb_add(&bar[XB_XGEN(b.x)], 1u);
            asm volatile("s_waitcnt vmcnt(0)" ::: "memory");
        } else {
            XB_SPIN(xb_ld(&bar[XB_XGEN(b.x)]) == gen, bar);
            __builtin_amdgcn_fence(__ATOMIC_ACQUIRE, "agent");
            asm volatile("s_waitcnt vmcnt(0)" ::: "memory");
        }
    }
    __syncthreads();
}
__device__ const float INVF_REV[128] = {1.591549367e-01f, 1.481051445e-01f, 1.378225088e-01f, 1.282537729e-01f, 1.193493679e-01f, 1.110631898e-01f, 1.033522934e-01f, 9.617675841e-02f, 8.949939907e-02f, 8.328563720e-02f, 7.750328630e-02f, 7.212239504e-02f, 6.711508334e-02f, 6.245541945e-02f, 5.811926723e-02f, 5.408416688e-02f, 5.032921210e-02f, 4.683495685e-02f, 4.358330369e-02f, 4.055740312e-02f, 3.774158657e-02f, 3.512126207e-02f, 3.268286586e-02f, 3.041376173e-02f, 2.830219641e-02f, 2.633723244e-02f, 2.450869232e-02f, 2.280710265e-02f, 2.122365311e-02f, 1.975013874e-02f, 1.837892644e-02f, 1.710291393e-02f, 1.591549441e-02f, 1.481051371e-02f, 1.378225069e-02f, 1.282537635e-02f, 1.193493698e-02f, 1.110631879e-02f, 1.033522934e-02f, 9.617676027e-03f, 8.949940093e-03f, 8.328564465e-03f, 7.750329096e-03f, 7.212239318e-03f, 6.711508147e-03f, 6.245541852e-03f, 5.811926909e-03f, 5.408416502e-03f, 5.032921210e-03f, 4.683495965e-03f, 4.358330276e-03f, 4.055740312e-03f, 3.774158424e-03f, 3.512126394e-03f, 3.268286586e-03f, 3.041376127e-03f, 2.830219688e-03f, 2.633723198e-03f, 2.450869186e-03f, 2.280710265e-03f, 2.122365171e-03f, 1.975013874e-03f, 1.837892574e-03f, 1.710291486e-03f, 1.591549488e-03f, 1.481051440e-03f, 1.378225046e-03f, 1.282537705e-03f, 1.193493721e-03f, 1.110631856e-03f, 1.033523004e-03f, 9.617675678e-04f, 8.949940093e-04f, 8.328563999e-04f, 7.750329096e-04f, 7.212239434e-04f, 6.711508031e-04f, 6.245541736e-04f, 5.811926676e-04f, 5.408416619e-04f, 5.032921326e-04f, 4.683495790e-04f, 4.358330334e-04f, 4.055740137e-04f, 3.774158540e-04f, 3.512126277e-04f, 3.268286528e-04f, 3.041376185e-04f, 2.830219455e-04f, 2.633723198e-04f, 2.450869069e-04f, 2.280710323e-04f, 2.122365258e-04f, 1.975013729e-04f, 1.837892632e-04f, 1.710291544e-04f, 1.591549371e-04f, 1.481051440e-04f, 1.378224988e-04f, 1.282537705e-04f, 1.193493736e-04f, 1.110631856e-04f, 1.033522931e-04f, 9.617675823e-05f, 8.949940093e-05f, 8.328563854e-05f, 7.750328950e-05f, 7.212239143e-05f, 6.711508468e-05f, 6.245542318e-05f, 5.811926894e-05f, 5.408416473e-05f, 5.032921035e-05f, 4.683495717e-05f, 4.358330261e-05f, 4.055740283e-05f, 3.774158540e-05f, 3.512126204e-05f, 3.268286673e-05f, 3.041376112e-05f, 2.830219637e-05f, 2.633723125e-05f, 2.450869215e-05f, 2.280710396e-05f, 2.122365186e-05f, 1.975013765e-05f, 1.837892523e-05f, 1.710291508e-05f};

constexpr size_t MiB = (size_t)1 << 20;
constexpr size_t WS_CTL = 0, CTL_ZERO_BYTES = 1 * MiB;
constexpr int CW_BAR = 4096, CW_MOECNT = 16384;
constexpr size_t WS_MOD = 1 * MiB;
constexpr size_t WS_TOK = 2 * MiB;
constexpr size_t WS_ROW = 3 * MiB;
constexpr size_t WS_W_RET_IN = 4 * MiB, WS_W_RET_OUT = 28 * MiB, WS_W_GM_IN = 36 * MiB, WS_W_GM_OUT = 48 * MiB, WS_W_NA_QKV = 54 * MiB, WS_W_NA_OUT = 60 * MiB;
constexpr size_t WS_W_MOE_GU = 64 * MiB, WS_W_MOE_DN = 192 * MiB;
constexpr size_t WS_PROJ = 256 * MiB;
constexpr size_t WS_REGB = 640 * MiB;
constexpr size_t WS_CROSSF = WS_REGB, WS_CROSSB = WS_REGB + 128 * MiB;
constexpr size_t WS_H = WS_REGB;
constexpr size_t WS_GMSTAT = WS_REGB + 64 * MiB;
constexpr size_t WS_H2S = WS_REGB;
constexpr size_t WS_HID = WS_REGB + 80 * MiB;
constexpr size_t WS_END = 896 * MiB;
constexpr int MOD_SH1 = 0, MOD_SC1 = 1024, MOD_G1 = 2048, MOD_SH2 = 3072, MOD_SC2 = 4096, MOD_G2 = 5120;

constexpr int NWAVES = 8, NTHREADS = 512;
constexpr int LDS_BYTES = 147456;
constexpr int MISC_OFF = LDS_BYTES - 256;

struct Params {
    const float *x, *c, *norm_g, *final_g, *w_ada, *b_ada, *ret_w_in, *ret_decay, *ret_w_out, *gm_w_in, *gm_ln_g, *gm_ln_b, *gm_w_s, *gm_b_s, *gm_w_out,
                *na_w_qkv, *na_rpb, *na_w_out, *router_w, *router_b, *moe_gu, *moe_dn;
    float* out; unsigned char* ws;
};

struct Frame {
    LAS unsigned char* lds; int tid, lane, wave, vcu, G;
};
__device__ __forceinline__ Frame relaunder(const Frame& F0) { Frame F = F0; int t = threadIdx.x; asm volatile("" : "+v"(t)); F.tid = t; F.lane = t & 63; F.wave = __builtin_amdgcn_readfirstlane(t >> 6); return F; }

__device__ __forceinline__ float wave_sum(float v) {
#pragma unroll
    for (int o = 1; o < 64; o <<= 1) v += __shfl_xor(v, o);
    return v;
}
#define LDS_WAIT() asm volatile("s_waitcnt lgkmcnt(0)" ::: "memory")

template <int ROWS, int COLS>
__device__ __forceinline__ void load_tile(LAS unsigned char* dst, int pitch, const bf16_t* src, size_t ld, int tid_) {
    constexpr int CPR = COLS / 8, TOTAL = ROWS * CPR;
    int tid = tid_; asm volatile("" : "+v"(tid));
#pragma unroll
    for (int i0 = 0; i0 < TOTAL; i0 += NTHREADS) { const int i = i0 + tid; if (TOTAL % NTHREADS == 0 || i < TOTAL) { const int r = i / CPR, c = i % CPR;
        const u32x4 v = *(const u32x4*)(src + (size_t)r * ld + c * 8); *(LAS u32x4*)(dst + r * pitch + c * 16) = v; } }
}
__device__ __forceinline__ bf16x8 tr_read2(const LAS unsigned char* a0, const LAS unsigned char* a1) {
    const s16x4 lo = __builtin_amdgcn_ds_read_tr16_b64_v4i16((LAS s16x4*)a0), hi = __builtin_amdgcn_ds_read_tr16_b64_v4i16((LAS s16x4*)a1);
    return __builtin_shufflevector(lo, hi, 0, 1, 2, 3, 4, 5, 6, 7);
}
__device__ __forceinline__ unsigned lds_addr(const LAS unsigned char* p) { return (unsigned)(unsigned long long)(uintptr_t)p; }
#define MFMA32(a, b, c) __builtin_amdgcn_mfma_f32_32x32x16_bf16((a), (b), (c), 0, 0, 0)
#define MFMA16(a, b, c) __builtin_amdgcn_mfma_f32_16x16x32_bf16((a), (b), (c), 0, 0, 0)
__device__ __forceinline__ f32x16 zero16() { f32x16 z; for (int i = 0; i < 16; ++i) z[i] = 0.f; return z; }

template <bool GU>
__device__ __forceinline__ void convert_weights(const Frame& F, const float* src, int nmat, int K, int N, bf16_t* dst) {
    const int gw = F.vcu * NWAVES + F.wave, NGW = F.G * NWAVES;
    const int nkb = K / 64, nnb = N / 32, per = nkb * nnb, total = per * nmat;
    const int kb8 = F.lane & 7, ng = F.lane >> 3;
    for (int it = gw; it < total; it += NGW) {
        const int mat = it / per, r = it % per, kb = r / nnb, nb = r % nnb, n0 = nb * 32, k0 = kb * 64;
        int drow0 = n0;
        if (GU) drow0 = (n0 < 512) ? ((n0 >> 7) * 256 + (n0 & 127)) : (((n0 - 512) >> 7) * 256 + 128 + ((n0 - 512) & 127));
        const float* sp = src + (size_t)mat * K * N + (size_t)(k0 + 8 * kb8) * N + n0 + 4 * ng;
        f32x4 v[8];
#pragma unroll
        for (int i = 0; i < 8; ++i) v[i] = __builtin_nontemporal_load((const f32x4*)(sp + (size_t)i * N));
        bf16_t* dp = dst + (size_t)mat * K * N + (size_t)(drow0 + 4 * ng) * K + k0 + 8 * kb8;
#pragma unroll
        for (int j = 0; j < 4; ++j) { u32x4 o; o.x = cvt_pk_bf16(v[0][j], v[1][j]); o.y = cvt_pk_bf16(v[2][j], v[3][j]); o.z = cvt_pk_bf16(v[4][j], v[5][j]); o.w = cvt_pk_bf16(v[6][j], v[7][j]);
            *(u32x4*)(dp + (size_t)j * K) = o; }
    }
}
__device__ __forceinline__ void p0_prologue(const Frame& F0, const Params& p) {
    const Frame F = relaunder(F0);
    {
        LAS float* cact = (LAS float*)F.lds;
        LAS float* part = (LAS float*)(F.lds + 16384);
        float* MOD = (float*)(p.ws + WS_MOD);
        bool loaded = false;
        for (int task = blockIdx.x; task < DEPTH * 48; task += F.G) {
            if (!loaded) { for (int i = F.tid; i < NB * D; i += NTHREADS) { const float v = p.c[i]; cact[i] = silu_f(v); } loaded = true; __syncthreads(); }
            const int layer = task / 48, cg = task % 48, c0 = cg * 128 + 2 * F.lane;
            float a[NB][2];
#pragma unroll
            for (int b = 0; b < NB; ++b) { a[b][0] = 0.f; a[b][1] = 0.f; }
            const float* wp = p.w_ada + ((size_t)layer * D + F.wave * 128) * 6144 + c0;
#pragma unroll 8
            for (int k = 0; k < 128; ++k) { const f32x2 wv = *(const f32x2*)(wp + (size_t)k * 6144);
#pragma unroll
                for (int b = 0; b < NB; ++b) { const float cv = cact[b * D + F.wave * 128 + k]; a[b][0] += cv * wv.x; a[b][1] += cv * wv.y; } }
#pragma unroll
            for (int b = 0; b < NB; ++b) { part[(F.wave * NB + b) * 128 + 2 * F.lane] = a[b][0]; part[(F.wave * NB + b) * 128 + 2 * F.lane + 1] = a[b][1]; }
            __syncthreads();
            { const int b = F.tid >> 7, col = F.tid & 127; float s = 0.f;
#pragma unroll
              for (int w = 0; w < NWAVES; ++w) s += part[(w * NB + b) * 128 + col];
              MOD[((size_t)layer * NB + b) * 6144 + cg * 128 + col] = s + p.b_ada[(size_t)layer * 6144 + cg * 128 + col]; }
            __syncthreads();
        }
        __syncthreads();
    }
    convert_weights<false>(F, p.ret_w_in, 2, D, RET_IN, (bf16_t*)(p.ws + WS_W_RET_IN));
    convert_weights<false>(F, p.ret_w_out, 2, 2048, D, (bf16_t*)(p.ws + WS_W_RET_OUT));
    convert_weights<false>(F, p.gm_w_in, 1, D, GM_FFN, (bf16_t*)(p.ws + WS_W_GM_IN));
    convert_weights<false>(F, p.gm_w_out, 1, GM_HALF, D, (bf16_t*)(p.ws + WS_W_GM_OUT));
    convert_weights<false>(F, p.na_w_qkv, 1, D, 3 * D, (bf16_t*)(p.ws + WS_W_NA_QKV));
    convert_weights<false>(F, p.na_w_out, 1, D, D, (bf16_t*)(p.ws + WS_W_NA_OUT));
    convert_weights<true>(F, p.moe_gu, DEPTH * 16, D, 1024, (bf16_t*)(p.ws + WS_W_MOE_GU));
    convert_weights<false>(F, p.moe_dn, DEPTH * 16, 512, D, (bf16_t*)(p.ws + WS_W_MOE_DN));
}

__device__ __forceinline__ void norm_phase(const Frame& F0, const float* xin, const float* ng, const float* modl  , int sh_off, int sc_off, bf16_t* H) {
    const Frame F = relaunder(F0);
    const int gw = F.vcu * NWAVES + F.wave, NGW = F.G * NWAVES;
    for (int rb = gw; rb < T / 16; rb += NGW) {
        const int row0 = rb * 16, b = row0 >> 13;
        f32x4 gs[4], sh[4];
#pragma unroll
        for (int j = 0; j < 4; ++j) { const int c = 4 * F.lane + 256 * j; const f32x4 g = *(const f32x4*)(ng + c), sc = *(const f32x4*)(modl + (size_t)b * 6144 + sc_off + c);
            gs[j] = g * (sc + 1.0f); sh[j] = *(const f32x4*)(modl + (size_t)b * 6144 + sh_off + c); }
        for (int r = 0; r < 16; ++r) {
            const float* xr = xin + (size_t)(row0 + r) * D + 4 * F.lane;
            f32x4 v[4]; float ss = 0.f;
#pragma unroll
            for (int j = 0; j < 4; ++j) { v[j] = *(const f32x4*)(xr + 256 * j); ss += (v[j].x * v[j].x + v[j].y * v[j].y) + (v[j].z * v[j].z + v[j].w * v[j].w); }
            const float rstd = 1.0f / sqrtf(wave_sum(ss) * (1.0f / D) + EPS);
            bf16_t* hr = H + (size_t)(row0 + r) * D + 4 * F.lane;
#pragma unroll
            for (int j = 0; j < 4; ++j) { const f32x4 o = v[j] * rstd * gs[j] + sh[j]; u32x2 w; w.x = cvt_pk_bf16(o.x, o.y); w.y = cvt_pk_bf16(o.z, o.w); *(u32x2*)(hr + 256 * j) = w; }
        }
    }
}
__device__ __forceinline__ void final_phase(const Frame& F0, float* x, const float* fg) {
    const Frame F = relaunder(F0);
    const int gw = F.vcu * NWAVES + F.wave, NGW = F.G * NWAVES;
    f32x4 g[4];
#pragma unroll
    for (int j = 0; j < 4; ++j) g[j] = *(const f32x4*)(fg + 4 * F.lane + 256 * j);
    for (int row = gw; row < T; row += NGW) {
        float* xr = x + (size_t)row * D + 4 * F.lane;
        f32x4 v[4]; float ss = 0.f;
#pragma unroll
        for (int j = 0; j < 4; ++j) { v[j] = *(const f32x4*)(xr + 256 * j); ss += (v[j].x * v[j].x + v[j].y * v[j].y) + (v[j].z * v[j].z + v[j].w * v[j].w); }
        const float rstd = 1.0f / sqrtf(wave_sum(ss) * (1.0f / D) + EPS);
#pragma unroll
        for (int j = 0; j < 4; ++j) *(f32x4*)(xr + 256 * j) = v[j] * rstd * g[j];
    }
}

typedef f32x4 AccT[2][2][4][2];
__device__ __forceinline__ void st8(bf16_t* p, const f32x4& v0, const f32x4& v1) {
    u32x4 w; w.x = cvt_pk_bf16(v0.x, v0.y); w.y = cvt_pk_bf16(v0.z, v0.w); w.z = cvt_pk_bf16(v1.x, v1.y); w.w = cvt_pk_bf16(v1.z, v1.w); *(u32x4*)p = w;
}
struct EpiRetIn {
    static constexpr bool PERM = true;
    bf16_t* O;
    __device__ __forceinline__ void operator()(const AccT& acc, const pg8::Unit& u, int wr, int wc, int fr, int fq) const {
        const int row0 = u.pm * 256 + wr * 64 + fr, col0 = u.pn * 256 + wc * 32 + 8 * fq;
        if (u.pn < 8) {
            const float osc = (u.pn >= 4) ? 0.0625f : 1.0f;
            float invf[8];
#pragma unroll
            for (int q = 0; q < 8; ++q) invf[q] = INVF_REV[wc * 32 + 8 * fq + q];
#pragma unroll
            for (int ai = 0; ai < 2; ++ai)
#pragma unroll
                for (int m = 0; m < 4; ++m) { const int row = row0 + ai * 128 + m * 16; const float pos = (float)(row & (SEQ - 1));
                    f32x4 o1[2], o2[2];
#pragma unroll
                    for (int n = 0; n < 2; ++n)
#pragma unroll
                        for (int j = 0; j < 4; ++j) { float rev = pos * invf[n * 4 + j]; rev -= floorf(rev);
                            const float sn = __builtin_amdgcn_sinf(rev), cs = __builtin_amdgcn_cosf(rev);
                            const float x1 = acc[ai][0][m][n][j], x2 = acc[ai][1][m][n][j];
                            o1[n][j] = (x1 * cs - x2 * sn) * osc; o2[n][j] = (x1 * sn + x2 * cs) * osc; }
                    bf16_t* rp = O + (size_t)row * RET_IN + col0;
                    st8(rp, o1[0], o1[1]); st8(rp + 128, o2[0], o2[1]); }
        } else {
#pragma unroll
            for (int ai = 0; ai < 2; ++ai)
#pragma unroll
                for (int m = 0; m < 4; ++m) { bf16_t* rp = O + (size_t)(row0 + ai * 128 + m * 16) * RET_IN + col0;
                    st8(rp, acc[ai][0][m][0], acc[ai][0][m][1]); st8(rp + 128, acc[ai][1][m][0], acc[ai][1][m][1]); }
        }
    }
};
struct EpiGmIn {
    static constexpr bool PERM = true;
    bf16_t* O; float* stat;
    __device__ __forceinline__ void operator()(const AccT& acc, const pg8::Unit& u, int wr, int wc, int fr, int fq) const {
        const int row0 = u.pm * 256 + wr * 64 + fr, col0 = u.pn * 256 + wc * 32 + 8 * fq;
        const bool vhalf = u.pn >= 12;
#pragma unroll
        for (int ai = 0; ai < 2; ++ai)
#pragma unroll
            for (int m = 0; m < 4; ++m) { const int row = row0 + ai * 128 + m * 16; bf16_t* rp = O + (size_t)row * GM_FFN + col0; float s1 = 0.f, s2 = 0.f;
#pragma unroll
                for (int bj = 0; bj < 2; ++bj) { f32x4 v[2];
#pragma unroll
                    for (int n = 0; n < 2; ++n) { const f32x4 a = acc[ai][bj][m][n]; const f32x2 g0 = pg8::gelu_pk((f32x2){a.x, a.y}), g1 = pg8::gelu_pk((f32x2){a.z, a.w}); v[n] = (f32x4){g0.x, g0.y, g1.x, g1.y};
                        s1 += (g0.x + g0.y) + (g1.x + g1.y); s2 += (g0.x * g0.x + g0.y * g0.y) + (g1.x * g1.x + g1.y * g1.y); }
                    st8(rp + bj * 128, v[0], v[1]); }
                if (vhalf) { s1 += __shfl_xor(s1, 16); s1 += __shfl_xor(s1, 32); s2 += __shfl_xor(s2, 16); s2 += __shfl_xor(s2, 32);
                    if (fq == 0) *(f32x2*)(stat + ((size_t)((u.pn - 12) * 4 + wc) * T + row) * 2) = (f32x2){s1, s2}; } }
    }
};
struct EpiNaIn {
    static constexpr bool PERM = true;
    bf16_t* O;
    __device__ __forceinline__ void operator()(const AccT& acc, const pg8::Unit& u, int wr, int wc, int fr, int fq) const {
        const int row0 = u.pm * 256 + wr * 64 + fr, col0 = u.pn * 256 + wc * 32 + 8 * fq;
        const float sc = (u.pn < 4) ? 0.17677669529663687f : 1.0f;
#pragma unroll
        for (int ai = 0; ai < 2; ++ai)
#pragma unroll
            for (int m = 0; m < 4; ++m) { bf16_t* rp = O + (size_t)(row0 + ai * 128 + m * 16) * 3072 + col0;
                st8(rp, acc[ai][0][m][0] * sc, acc[ai][0][m][1] * sc); st8(rp + 128, acc[ai][1][m][0] * sc, acc[ai][1][m][1] * sc); }
    }
};
struct EpiResid {
    static constexpr bool PERM = false;
    const float* xin; float* xout; const float* g;
    __device__ __forceinline__ void operator()(const AccT& acc, const pg8::Unit& u, int wr, int wc, int fr, int fq) const {
        const int row0 = u.pm * 256 + wr * 64 + fr, col0 = u.pn * 256 + wc * 32 + 4 * fq, b = (u.pm * 256) >> 13;
        f32x4 gv[2][2];
#pragma unroll
        for (int bj = 0; bj < 2; ++bj)
#pragma unroll
            for (int n = 0; n < 2; ++n) gv[bj][n] = *(const f32x4*)(g + (size_t)b * 6144 + col0 + bj * 128 + n * 16);
#pragma unroll
        for (int ai = 0; ai < 2; ++ai)
#pragma unroll
            for (int m = 0; m < 4; ++m) { const size_t off = (size_t)(row0 + ai * 128 + m * 16) * D + col0;
#pragma unroll
                for (int bj = 0; bj < 2; ++bj)
#pragma unroll
                    for (int n = 0; n < 2; ++n) { const f32x4 xv = *(const f32x4*)(xin + off + bj * 128 + n * 16); *(f32x4*)(xout + off + bj * 128 + n * 16) = xv + gv[bj][n] * acc[ai][bj][m][n]; } }
    }
};
struct EpiMoeGU {
    static constexpr bool PERM = true;
    bf16_t* hid; const float* rowwa; const float* rowwb;
    __device__ __forceinline__ void operator()(const AccT& acc, const pg8::Unit& u, int wr, int wc, int fr, int fq) const {
        const int row0 = u.pm * 256 + wr * 64 + fr, col0 = (u.pn >> 2) * 512 + (u.pn & 3) * 128 + wc * 32 + 8 * fq;
        const float* wsel = (u.pn < 4) ? rowwa : rowwb;
#pragma unroll
        for (int ai = 0; ai < 2; ++ai)
#pragma unroll
            for (int m = 0; m < 4; ++m) { const int row = row0 + ai * 128 + m * 16; const float w = wsel[row]; f32x4 v[2];
#pragma unroll
                for (int n = 0; n < 2; ++n)
#pragma unroll
                    for (int j = 0; j < 4; ++j) v[n][j] = w * silu_f(acc[ai][0][m][n][j]) * acc[ai][1][m][n][j];
                st8(hid + (size_t)row * 1024 + col0, v[0], v[1]); }
    }
};
struct EpiMoeDown {
    static constexpr bool PERM = false;
    float* x; const int* rowtok; const float* g;
    __device__ __forceinline__ void operator()(const AccT& acc, const pg8::Unit& u, int wr, int wc, int fr, int fq) const {
        const int row0 = u.pm * 256 + wr * 64 + fr, col0 = u.pn * 256 + wc * 32 + 4 * fq;
#pragma unroll
        for (int ai = 0; ai < 2; ++ai)
#pragma unroll
            for (int m = 0; m < 4; ++m) { const int tok = rowtok[row0 + ai * 128 + m * 16];
                if (tok >= 0) { const size_t off = (size_t)tok * D + col0; const float* gp = g + (size_t)(tok >> 13) * 6144 + col0;
#pragma unroll
                    for (int bj = 0; bj < 2; ++bj)
#pragma unroll
                        for (int n = 0; n < 2; ++n) { const f32x4 xv = *(const f32x4*)(x + off + bj * 128 + n * 16), gv = *(const f32x4*)(gp + bj * 128 + n * 16);
                            *(f32x4*)(x + off + bj * 128 + n * 16) = xv + gv * acc[ai][bj][m][n]; } } }
    }
};

__device__ __forceinline__ float second_of4_sum(float a, float b, float c, float d) {
    const float hi1 = fmaxf(a, b), lo1 = fminf(a, b), hi2 = fmaxf(c, d), lo2 = fminf(c, d);
    return fmaxf(hi1, hi2) + fmaxf(fminf(hi1, hi2), fmaxf(lo1, lo2));
}
__device__ __forceinline__ void moe_route_phase(const Frame& F0, const Params& p, int layer, const float* x) {
    const Frame F = relaunder(F0);
    LAS float* BpT = (LAS float*)F.lds;
    LAS float* cb = (LAS float*)(F.lds + 65536);
    LAS int* tcls = (LAS int*)(F.lds + 65536 + 128);
    LAS float* twa = (LAS float*)(F.lds + 65536 + 128 + 512);
    LAS float* twb = (LAS float*)(F.lds + 65536 + 128 + 1024);
    LAS int* cbase = (LAS int*)(F.lds + 65536 + 128 + 1536);
    const float* modl = (const float*)(p.ws + WS_MOD) + (size_t)layer * NB * 6144;
    const float* ng = p.norm_g + (size_t)(layer * 2 + 1) * D;
    unsigned* cnt = (unsigned*)(p.ws + WS_CTL) + CW_MOECNT + layer * 32;
    int* tok_cls = (int*)(p.ws + WS_TOK); int* tok_slot = tok_cls + T; float* tok_wa = (float*)(tok_slot + T); float* tok_wb = tok_wa + T;
    float rb[16];
#pragma unroll
    for (int e = 0; e < 16; ++e) rb[e] = p.router_b[e];
    int built_b = -1;
    for (int chunk = blockIdx.x; chunk < T / 128; chunk += F.G) {
        const int b = chunk >> 6;
        if (b != built_b) {
            for (int k = F.tid; k < D; k += NTHREADS) { const float gs = ng[k] * (1.0f + modl[(size_t)b * 6144 + MOD_SC2 + k]);
#pragma unroll
                for (int q = 0; q < 4; ++q) { const f32x4 r = *(const f32x4*)(p.router_w + (size_t)k * 16 + 4 * q);
                    BpT[(4 * q + 0) * D + k] = gs * r.x; BpT[(4 * q + 1) * D + k] = gs * r.y; BpT[(4 * q + 2) * D + k] = gs * r.z; BpT[(4 * q + 3) * D + k] = gs * r.w; } }
#pragma unroll
            for (int q = 0; q < 2; ++q) { const int e = 2 * F.wave + q; float s = 0.f;
                for (int k = F.lane; k < D; k += 64) s += modl[(size_t)b * 6144 + MOD_SH2 + k] * p.router_w[(size_t)k * 16 + e];
                s = wave_sum(s); if (F.lane == 0) cb[e] = s; }
            built_b = b;
        }
        __syncthreads();
        for (int i = 0; i < 16; ++i) {
            const int ti = F.wave * 16 + i, tok = chunk * 128 + ti;
            const float* xr = x + (size_t)tok * D + 4 * F.lane;
            f32x4 v[4]; float ss = 0.f;
#pragma unroll
            for (int j = 0; j < 4; ++j) { v[j] = *(const f32x4*)(xr + 256 * j); ss += (v[j].x * v[j].x + v[j].y * v[j].y) + (v[j].z * v[j].z + v[j].w * v[j].w); }
            float pe[16];
#pragma unroll
            for (int e = 0; e < 16; ++e) { float s = 0.f;
#pragma unroll
                for (int j = 0; j < 4; ++j) { const f32x4 w = *(const LAS f32x4*)(BpT + e * D + 4 * F.lane + 256 * j); s += (v[j].x * w.x + v[j].y * w.y) + (v[j].z * w.z + v[j].w * w.w); }
                pe[e] = s; }
            ss = wave_sum(ss);
#pragma unroll
            for (int e = 0; e < 16; ++e) pe[e] = wave_sum(pe[e]);
            const float rstd = 1.0f / sqrtf(ss * (1.0f / D) + EPS);
            float sc[16], bi[16];
#pragma unroll
            for (int e = 0; e < 16; ++e) { const float lg = rstd * pe[e] + cb[e]; sc[e] = 1.0f / (1.0f + __expf(-lg)); bi[e] = sc[e] + rb[e]; }
            float gsum[4];
#pragma unroll
            for (int g = 0; g < 4; ++g) gsum[g] = second_of4_sum(bi[4 * g], bi[4 * g + 1], bi[4 * g + 2], bi[4 * g + 3]);
            int grp = 0; float best = gsum[0];
#pragma unroll
            for (int g = 1; g < 4; ++g) if (gsum[g] > best) { best = gsum[g]; grp = g; }
            float vb[4], vs[4];
#pragma unroll
            for (int q = 0; q < 4; ++q) { vb[q] = grp == 0 ? bi[q] : grp == 1 ? bi[4 + q] : grp == 2 ? bi[8 + q] : bi[12 + q]; vs[q] = grp == 0 ? sc[q] : grp == 1 ? sc[4 + q] : grp == 2 ? sc[8 + q] : sc[12 + q]; }
            int i1 = 0; float m1 = vb[0];
#pragma unroll
            for (int q = 1; q < 4; ++q) if (vb[q] > m1) { m1 = vb[q]; i1 = q; }
            int i2 = -1; float m2 = -3.0e38f;
#pragma unroll
            for (int q = 0; q < 4; ++q) if (q != i1 && vb[q] > m2) { m2 = vb[q]; i2 = q; }
            const int la = i1 < i2 ? i1 : i2, lb = i1 < i2 ? i2 : i1;
            const float sa = la == 0 ? vs[0] : la == 1 ? vs[1] : vs[2], sb = lb == 1 ? vs[1] : lb == 2 ? vs[2] : vs[3];
            const float inv = 1.0f / (sa + sb);
            const int pi = la == 0 ? lb - 1 : la == 1 ? lb + 1 : 5;
            if (F.lane == 0) { tcls[ti] = grp * 6 + pi; twa[ti] = sa * inv; twb[ti] = sb * inv; }
        }
        __syncthreads();
        if (F.tid < NCLS) { int n = 0; for (int j = 0; j < 128; ++j) n += (tcls[j] == F.tid) ? 1 : 0; cbase[F.tid] = n ? (int)atomicAdd(cnt + F.tid, (unsigned)n) : 0; }
        __syncthreads();
        if (F.tid < 128) { const int cls = tcls[F.tid]; int rank = 0; for (int j = 0; j < F.tid; ++j) rank += (tcls[j] == cls) ? 1 : 0;
            const int tok = chunk * 128 + F.tid; tok_cls[tok] = cls; tok_slot[tok] = cbase[cls] + rank; tok_wa[tok] = twa[F.tid]; tok_wb[tok] = twb[F.tid]; }
        __syncthreads();
    }
}
__device__ __forceinline__ void moe_offsets(const Frame& F, const unsigned* cnt, LAS int* off) {
    if (F.tid == 0) { int o = 0; for (int c = 0; c < NCLS; ++c) { off[c] = o; const int n = (int)__hip_atomic_load(cnt + c, __ATOMIC_RELAXED, __HIP_MEMORY_SCOPE_AGENT); o += ((n + 255) >> 8) << 8; } off[NCLS] = o; }
    __syncthreads();
}
__device__ __forceinline__ void moe_gather_phase(const Frame& F0, const Params& p, int layer, const float* x) {
    const Frame F = relaunder(F0);
    LAS int* off = (LAS int*)F.lds;
    const unsigned* cnt = (const unsigned*)(p.ws + WS_CTL) + CW_MOECNT + layer * 32;
    moe_offsets(F, cnt, off);
    const float* modl = (const float*)(p.ws + WS_MOD) + (size_t)layer * NB * 6144;
    const float* ng = p.norm_g + (size_t)(layer * 2 + 1) * D;
    const int* tok_cls = (const int*)(p.ws + WS_TOK); const int* tok_slot = tok_cls + T; const float* tok_wa = (const float*)(tok_slot + T); const float* tok_wb = tok_wa + T;
    int* rowtok = (int*)(p.ws + WS_ROW); float* rowwa = (float*)(rowtok + MOE_ROWS); float* rowwb = rowwa + MOE_ROWS;
    bf16_t* h2s = (bf16_t*)(p.ws + WS_H2S);
    const int gw = F.vcu * NWAVES + F.wave, NGW = F.G * NWAVES;
    for (int rbk = gw; rbk < T / 16; rbk += NGW) {
        const int row0 = rbk * 16, b = row0 >> 13;
        f32x4 gs[4], sh[4];
#pragma unroll
        for (int j = 0; j < 4; ++j) { const int c = 4 * F.lane + 256 * j; const f32x4 g = *(const f32x4*)(ng + c), sc = *(const f32x4*)(modl + (size_t)b * 6144 + MOD_SC2 + c);
            gs[j] = g * (sc + 1.0f); sh[j] = *(const f32x4*)(modl + (size_t)b * 6144 + MOD_SH2 + c); }
        for (int r = 0; r < 16; ++r) {
            const int tok = row0 + r;
            const float* xr = x + (size_t)tok * D + 4 * F.lane;
            f32x4 v[4]; float ss = 0.f;
#pragma unroll
            for (int j = 0; j < 4; ++j) { v[j] = *(const f32x4*)(xr + 256 * j); ss += (v[j].x * v[j].x + v[j].y * v[j].y) + (v[j].z * v[j].z + v[j].w * v[j].w); }
            const float rstd = 1.0f / sqrtf(wave_sum(ss) * (1.0f / D) + EPS);
            const int pos = off[tok_cls[tok]] + tok_slot[tok];
            bf16_t* hr = h2s + (size_t)pos * D + 4 * F.lane;
#pragma unroll
            for (int j = 0; j < 4; ++j) { const f32x4 o = v[j] * rstd * gs[j] + sh[j]; u32x2 w; w.x = cvt_pk_bf16(o.x, o.y); w.y = cvt_pk_bf16(o.z, o.w); *(u32x2*)(hr + 256 * j) = w; }
            if (F.lane == 0) { rowtok[pos] = tok; rowwa[pos] = tok_wa[tok]; rowwb[pos] = tok_wb[tok]; }
        }
    }
    for (int cls = blockIdx.x; cls < NCLS; cls += F.G) {
        const int n = (int)__hip_atomic_load(cnt + cls, __ATOMIC_RELAXED, __HIP_MEMORY_SCOPE_AGENT);
        const int r0 = off[cls] + n, r1 = off[cls + 1];
        for (int r = r0; r < r1; ++r) { ((unsigned*)(h2s + (size_t)r * D))[F.tid] = 0u; if (F.tid == 0) { rowtok[r] = -1; rowwa[r] = 0.f; rowwb[r] = 0.f; } }
    }
}
struct MoeSched {
    int G, c, NP, NT; const LAS int* tile_cls; const char* Abase; const char* Wbase; size_t wmat, bntile;
    __device__ bool next(int i, pg8::Unit& u) const {
        const int L = i * G + c; if (L >= NT * NP) return false;
        const int rt = L / NP, pn = L % NP, cls = tile_cls[rt], grp = cls / 6, pi = cls % 6;
        const int la = pi < 3 ? 0 : (pi < 5 ? 1 : 2), lb = pi < 3 ? pi + 1 : (pi < 5 ? pi - 1 : 3);
        const int ea = grp * 4 + la, eb = grp * 4 + lb;
        u.pm = rt; u.pn = pn; u.aux = 0; u.A = Abase + (size_t)rt * 256 * 1024 * 2;
        if (NP == 8) { const int e = pn < 4 ? ea : eb; u.B = Wbase + (size_t)e * wmat + (size_t)(pn & 3) * bntile; u.B2 = u.B; }
        else { u.B = Wbase + (size_t)ea * wmat + (size_t)pn * bntile; u.B2 = Wbase + (size_t)eb * wmat + (size_t)pn * bntile; }
        return true;
    }
};
__device__ __forceinline__ int moe_tile_table(const Frame& F, const unsigned* cnt, LAS int* tab) {
    if (F.tid == 0) { int rt = 0; for (int c = 0; c < NCLS; ++c) { const int n = (int)__hip_atomic_load(cnt + c, __ATOMIC_RELAXED, __HIP_MEMORY_SCOPE_AGENT); const int nt = (n + 255) >> 8; for (int k = 0; k < nt; ++k) tab[rt++] = c; } tab[255] = rt; }
    __syncthreads();
    return tab[255];
}

__device__ __forceinline__ float log2_gamma(const float* decay_logit) {
    const float xv = *decay_logit; return -log1pf(__expf(-xv)) * LOG2E;
}
__device__ __forceinline__ u32x2 pack4(float a, float b, float c, float d) { u32x2 w; w.x = cvt_pk_bf16(a, b); w.y = cvt_pk_bf16(c, d); return w; }
__device__ __forceinline__ void ret_chain_phase(const Frame& F0, const Params& p, int j) {
    const Frame F = relaunder(F0);
    constexpr int PQ = 528, PV = 144;
    LAS unsigned char* bufQK = F.lds; LAS unsigned char* bufV = F.lds + 128 * PQ; LAS unsigned char* ST = bufV + 128 * PV;
    const bf16_t* PROJ = (const bf16_t*)(p.ws + WS_PROJ);
    const int lane = F.lane, w = F.wave, l32 = lane & 31, hh = lane >> 5, blk = (lane >> 4) & 1, q4 = (lane & 15) >> 2, p4 = lane & 3;
    for (int chain = F.vcu; chain < 256; chain += F.G) {
        const int b = chain >> 6, h = (chain >> 4) & 3, dir = (chain >> 3) & 1, sl = chain & 7;
        const float lg2 = log2_gamma(p.ret_decay + (size_t)j * 8 + dir * 4 + h);
        bf16_t* CROSS = (bf16_t*)(p.ws + (dir ? WS_CROSSB : WS_CROSSF));
        const float dec = fast_exp2(lg2 * 128.0f);
        f32x16 sacc[2]; sacc[0] = zero16(); sacc[1] = zero16();
        __syncthreads();
        for (int i = F.tid; i < 64 * PQ / 16; i += NTHREADS) *(LAS u32x4*)(ST + i * 16) = (u32x4){0u, 0u, 0u, 0u};
        for (int step = 0; step < 64; ++step) {
            const int n = dir ? 63 - step : step;
            const size_t tok0 = (size_t)b * SEQ + (size_t)n * 128;
            load_tile<128, 256>(bufQK, PQ, PROJ + tok0 * RET_IN + h * 256, RET_IN, F.tid);
            __syncthreads();
            {
                const int ct = w >> 1, et = w & 1;
                f32x16 acc = zero16();
#pragma unroll
                for (int ks = 0; ks < 16; ++ks) {
                    const bf16x8 a = *(const LAS bf16x8*)(ST + (32 * et + l32) * PQ + (16 * ks + 8 * hh) * 2);
                    const bf16x8 bq = *(const LAS bf16x8*)(bufQK + (32 * ct + l32) * PQ + (16 * ks + 8 * hh) * 2);
                    acc = MFMA32(a, bq, acc);
                }
                const int c = 32 * ct + l32;
                const float xi = dir ? fast_exp2(lg2 * (float)(128 - c)) : fast_exp2(lg2 * (float)(c + 1));
                bf16_t* op = CROSS + (tok0 + c) * 2048 + h * 512 + sl * 64 + 32 * et + 4 * hh;
#pragma unroll
                for (int g4 = 0; g4 < 4; ++g4) *(u32x2*)(op + 8 * g4) = pack4(acc[4 * g4] * xi, acc[4 * g4 + 1] * xi, acc[4 * g4 + 2] * xi, acc[4 * g4 + 3] * xi);
            }
            __syncthreads();
            load_tile<128, 256>(bufQK, PQ, PROJ + tok0 * RET_IN + 1024 + h * 256, RET_IN, F.tid);
#pragma unroll
            for (int i0 = 0; i0 < 1024; i0 += NTHREADS) { const int i = i0 + F.tid, r = i >> 3, c8 = i & 7;
                const u32x4 v = *(const u32x4*)(PROJ + (tok0 + r) * RET_IN + 2048 + h * 512 + sl * 64 + c8 * 8);
                const float z = dir ? fast_exp2(lg2 * (float)r) : fast_exp2(lg2 * (float)(127 - r));
                u32x4 o; o.x = cvt_pk_bf16(bf_lo(v.x) * z, bf_hi(v.x) * z); o.y = cvt_pk_bf16(bf_lo(v.y) * z, bf_hi(v.y) * z); o.z = cvt_pk_bf16(bf_lo(v.z) * z, bf_hi(v.z) * z); o.w = cvt_pk_bf16(bf_lo(v.w) * z, bf_hi(v.w) * z);
                *(LAS u32x4*)(bufV + r * PV + c8 * 16) = o; }
            __syncthreads();
            {
#pragma unroll
                for (int i = 0; i < 16; ++i) { sacc[0][i] *= dec; sacc[1][i] *= dec; }
                const LAS unsigned char* aK = bufQK + (8 * hh + q4) * PQ + 64 * w + 32 * blk + 8 * p4;
                const LAS unsigned char* aV = bufV + (8 * hh + q4) * PV + 32 * blk + 8 * p4;
#pragma unroll
                for (int ks = 0; ks < 8; ++ks) {
                    const bf16x8 ka = tr_read2(aK + (16 * ks) * PQ, aK + (16 * ks + 4) * PQ);
                    const bf16x8 v0 = tr_read2(aV + (16 * ks) * PV, aV + (16 * ks + 4) * PV);
                    const bf16x8 v1 = tr_read2(aV + (16 * ks) * PV + 64, aV + (16 * ks + 4) * PV + 64);
                    sacc[0] = MFMA32(ka, v0, sacc[0]); sacc[1] = MFMA32(ka, v1, sacc[1]);
                }
#pragma unroll
                for (int et = 0; et < 2; ++et)
#pragma unroll
                    for (int g4 = 0; g4 < 4; ++g4) *(LAS u32x2*)(ST + (32 * et + l32) * PQ + (32 * w + 8 * g4 + 4 * hh) * 2) = pack4(sacc[et][4 * g4], sacc[et][4 * g4 + 1], sacc[et][4 * g4 + 2], sacc[et][4 * g4 + 3]);
            }
            __syncthreads();
        }
    }
}
__device__ __forceinline__ void ret_intra_phase(const Frame& F0, const Params& p, int j) {
    const Frame F = relaunder(F0);
    constexpr int PQ = 528, PP = 272;
    LAS unsigned char* R0 = F.lds; LAS unsigned char* R1 = F.lds + 128 * PQ; LAS float* red = (LAS float*)(F.lds + 2 * 128 * PQ);
    bf16_t* PROJ = (bf16_t*)(p.ws + WS_PROJ);
    const bf16_t* CF = (const bf16_t*)(p.ws + WS_CROSSF); const bf16_t* CB = (const bf16_t*)(p.ws + WS_CROSSB);
    const int lane0 = F.lane, w = F.wave;
    for (int unit = F.vcu; unit < 1024; unit += F.G) {
        int lane = lane0; asm volatile("" : "+v"(lane));
        const int l32 = lane & 31, hh = lane >> 5, blk = (lane >> 4) & 1, q4 = (lane & 15) >> 2, p4 = lane & 3;
        const int b = unit >> 8, h = (unit >> 6) & 3, n = unit & 63;
        const float lgf = log2_gamma(p.ret_decay + (size_t)j * 8 + h), lgb = log2_gamma(p.ret_decay + (size_t)j * 8 + 4 + h);
        const size_t tok0 = (size_t)b * SEQ + (size_t)n * 128;
        __syncthreads();
        load_tile<128, 256>(R0, PQ, PROJ + tok0 * RET_IN + h * 256, RET_IN, F.tid);
        load_tile<128, 256>(R1, PQ, PROJ + tok0 * RET_IN + 1024 + h * 256, RET_IN, F.tid);
        __syncthreads();
        {
            const int mt = w >> 1;
            f32x16 pacc[2]; pacc[0] = zero16(); pacc[1] = zero16();
#pragma unroll
            for (int ks = 0; ks < 16; ++ks) {
                const bf16x8 a = *(const LAS bf16x8*)(R1 + (32 * mt + l32) * PQ + (16 * ks + 8 * hh) * 2);
#pragma unroll
                for (int ci = 0; ci < 2; ++ci) { const int ct = 2 * (w & 1) + ci;
                    const bf16x8 bq = *(const LAS bf16x8*)(R0 + (32 * ct + l32) * PQ + (16 * ks + 8 * hh) * 2);
                    pacc[ci] = MFMA32(a, bq, pacc[ci]); }
            }
#pragma unroll
            for (int ci = 0; ci < 2; ++ci) { const int c = 32 * (2 * (w & 1) + ci) + l32;
#pragma unroll
                for (int i = 0; i < 16; ++i) { const int m = 32 * mt + (i & 3) + 8 * (i >> 2) + 4 * hh; const int dl = c - m;
                    pacc[ci][i] *= (dl >= 0) ? fast_exp2(lgf * (float)dl) : fast_exp2(lgb * (float)(-dl)); } }
            __syncthreads();
#pragma unroll
            for (int ci = 0; ci < 2; ++ci) { const int c = 32 * (2 * (w & 1) + ci) + l32;
#pragma unroll
                for (int g4 = 0; g4 < 4; ++g4) *(LAS u32x2*)(R0 + c * PP + (32 * mt + 8 * g4 + 4 * hh) * 2) = pack4(pacc[ci][4 * g4], pacc[ci][4 * g4 + 1], pacc[ci][4 * g4 + 2], pacc[ci][4 * g4 + 3]); }
        }
        f32x16 oacc[2][4];
#pragma unroll
        for (int hf = 0; hf < 2; ++hf)
#pragma unroll
            for (int e = 0; e < 4; ++e) oacc[hf][e] = zero16();
        const int ct = w & 3, eg = w >> 2;
#pragma unroll
        for (int hf = 0; hf < 2; ++hf) {
            if (hf == 1) __syncthreads();
            load_tile<128, 256>(R1, PQ, PROJ + tok0 * RET_IN + 2048 + h * 512 + hf * 256, RET_IN, F.tid);
            __syncthreads();
            const LAS unsigned char* aV = R1 + (8 * hh + q4) * PQ + 32 * blk + 8 * p4;
#pragma unroll
            for (int ks = 0; ks < 8; ++ks) {
                const bf16x8 pb = *(const LAS bf16x8*)(R0 + (32 * ct + l32) * PP + (16 * ks + 8 * hh) * 2);
#pragma unroll
                for (int e = 0; e < 4; ++e) { const int et = 4 * eg + e;
                    const bf16x8 va = tr_read2(aV + (16 * ks) * PQ + 64 * et, aV + (16 * ks + 4) * PQ + 64 * et);
                    oacc[hf][e] = MFMA32(va, pb, oacc[hf][e]); }
            }
        }
        const size_t tok = tok0 + 32 * ct + l32;
        float ss = 0.f;
        u32x2 opk[2][4][4];
#pragma unroll
        for (int hf = 0; hf < 2; ++hf)
#pragma unroll
            for (int e = 0; e < 4; ++e)
#pragma unroll
                for (int g4 = 0; g4 < 4; ++g4) { const int e0 = hf * 256 + 32 * (4 * eg + e) + 8 * g4 + 4 * hh;
                    const u32x2 cf = *(const u32x2*)(CF + tok * 2048 + h * 512 + e0), cbv = *(const u32x2*)(CB + tok * 2048 + h * 512 + e0);
                    const float o0 = oacc[hf][e][4 * g4] + bf_lo(cf.x) + bf_lo(cbv.x), o1 = oacc[hf][e][4 * g4 + 1] + bf_hi(cf.x) + bf_hi(cbv.x);
                    const float o2 = oacc[hf][e][4 * g4 + 2] + bf_lo(cf.y) + bf_lo(cbv.y), o3 = oacc[hf][e][4 * g4 + 3] + bf_hi(cf.y) + bf_hi(cbv.y);
                    opk[hf][e][g4] = pack4(o0, o1, o2, o3);
                    asm volatile("" : "+v"(opk[hf][e][g4]));
                    ss += (o0 * o0 + o1 * o1) + (o2 * o2 + o3 * o3);
                    if (g4 & 1) asm volatile("" ::: "memory"); }
        ss += __shfl_xor(ss, 32);
        if (hh == 0) red[(32 * ct + l32) * 2 + eg] = ss;
        __syncthreads();
        const float rstd = 1.0f / sqrtf((red[(32 * ct + l32) * 2] + red[(32 * ct + l32) * 2 + 1]) * (1.0f / 512.0f) + EPS);
#pragma unroll
        for (int hf = 0; hf < 2; ++hf)
#pragma unroll
            for (int e = 0; e < 4; ++e)
#pragma unroll
                for (int g4 = 0; g4 < 4; ++g4) { const int e0 = hf * 256 + 32 * (4 * eg + e) + 8 * g4 + 4 * hh;
                    bf16_t* gp = PROJ + tok * RET_IN + 4096 + h * 512 + e0; const u32x2 gv = *(const u32x2*)gp; const u32x2 ov = opk[hf][e][g4];
                    *(u32x2*)gp = pack4(bf_lo(ov.x) * rstd * silu_f(bf_lo(gv.x)), bf_hi(ov.x) * rstd * silu_f(bf_hi(gv.x)),
                                        bf_lo(ov.y) * rstd * silu_f(bf_lo(gv.y)), bf_hi(ov.y) * rstd * silu_f(bf_hi(gv.y)));
                    if (g4 & 1) asm volatile("" ::: "memory"); }
    }
}

__device__ __forceinline__ void gm_spatial_phase(const Frame& F0, const Params& p) {
    const Frame F = relaunder(F0);
    constexpr int PW = 272, PVV = 528;
    LAS unsigned char* Wp = F.lds; LAS unsigned char* Vt = F.lds + 128 * PW;
    LAS float* mu = (LAS float*)(F.lds + 128 * PW + 128 * PVV); LAS float* rs = mu + 128; LAS float* corr = rs + 128; LAS float* rsw = corr + 128;
    bf16_t* PROJ = (bf16_t*)(p.ws + WS_PROJ);
    const float* stat = (const float*)(p.ws + WS_GMSTAT);
    const int lane = F.lane, w = F.wave, l32 = lane & 31, hh = lane >> 5, blk = (lane >> 4) & 1, q4 = (lane & 15) >> 2, p4 = lane & 3;
    for (int unit = F.vcu; unit < NB * 64 * 4 * 3; unit += F.G) {
        const int th = unit % 3, g = (unit / 3) & 3, n = (unit / 12) & 63, b = unit / 768;
        const size_t tok0 = (size_t)b * SEQ + (size_t)n * 128;
        const int cbase = g * 768 + th * 256;
        __syncthreads();
        if (F.tid < 128) { float s1 = 0.f, s2 = 0.f;
            for (int q = 0; q < 48; ++q) { const f32x2 v = *(const f32x2*)(stat + ((size_t)q * T + tok0 + F.tid) * 2); s1 += v.x; s2 += v.y; }
            const float m = s1 * (1.0f / GM_HALF), var = fmaxf(s2 * (1.0f / GM_HALF) - m * m, 0.f);
            mu[F.tid] = m; rs[F.tid] = 1.0f / sqrtf(var + EPS); }
        load_tile<128, 256>(Vt, PVV, PROJ + tok0 * GM_FFN + GM_HALF + cbase, GM_FFN, F.tid);
        __syncthreads();
        {
            const int t = F.tid >> 2, qd = F.tid & 3; const float* wrow = p.gm_w_s + ((size_t)g * 128 + t) * 128 + 32 * qd;
            float cs = 0.f, rw = 0.f;
#pragma unroll
            for (int i = 0; i < 8; ++i) { const f32x4 wv = *(const f32x4*)(wrow + 4 * i); const int s = 32 * qd + 4 * i;
                const float r0 = rs[s], r1 = rs[s + 1], r2 = rs[s + 2], r3 = rs[s + 3];
                const float a0 = wv.x * r0, a1 = wv.y * r1, a2 = wv.z * r2, a3 = wv.w * r3;
                cs += (a0 * mu[s] + a1 * mu[s + 1]) + (a2 * mu[s + 2] + a3 * mu[s + 3]); rw += (wv.x + wv.y) + (wv.z + wv.w);
                *(LAS u32x2*)(Wp + t * PW + s * 2) = pack4(a0, a1, a2, a3); }
            cs += __shfl_xor(cs, 1); cs += __shfl_xor(cs, 2); rw += __shfl_xor(rw, 1); rw += __shfl_xor(rw, 2);
            if (qd == 0) { corr[t] = cs; rsw[t] = rw; }
        }
        __syncthreads();
        const int tt = w & 3, cg = w >> 2;
        f32x16 acc[4];
#pragma unroll
        for (int e = 0; e < 4; ++e) acc[e] = zero16();
        const LAS unsigned char* aV = Vt + (8 * hh + q4) * PVV + 32 * blk + 8 * p4;
#pragma unroll
        for (int ks = 0; ks < 8; ++ks) {
            const bf16x8 wb = *(const LAS bf16x8*)(Wp + (32 * tt + l32) * PW + (16 * ks + 8 * hh) * 2);
#pragma unroll
            for (int e = 0; e < 4; ++e) { const int ct = 4 * cg + e;
                const bf16x8 va = tr_read2(aV + (16 * ks) * PVV + 64 * ct, aV + (16 * ks + 4) * PVV + 64 * ct);
                acc[e] = MFMA32(va, wb, acc[e]); }
        }
        const int t = 32 * tt + l32; const float co = corr[t], rwt = rsw[t], bs = p.gm_b_s[g * 128 + t];
#pragma unroll
        for (int e = 0; e < 4; ++e)
#pragma unroll
            for (int g4 = 0; g4 < 4; ++g4) { const int c0 = cbase + 32 * (4 * cg + e) + 8 * g4 + 4 * hh;
                const f32x4 lg = *(const f32x4*)(p.gm_ln_g + c0), lb = *(const f32x4*)(p.gm_ln_b + c0);
                bf16_t* up = PROJ + (tok0 + t) * GM_FFN + c0; const u32x2 uv = *(const u32x2*)up;
                const float m0 = lg.x * (acc[e][4 * g4] - co) + lb.x * rwt + bs, m1 = lg.y * (acc[e][4 * g4 + 1] - co) + lb.y * rwt + bs;
                const float m2 = lg.z * (acc[e][4 * g4 + 2] - co) + lb.z * rwt + bs, m3 = lg.w * (acc[e][4 * g4 + 3] - co) + lb.w * rwt + bs;
                *(u32x2*)up = pack4(bf_lo(uv.x) * m0, bf_hi(uv.x) * m1, bf_lo(uv.y) * m2, bf_hi(uv.y) * m3); }
    }
}

__device__ __forceinline__ void na_attn_phase(const Frame& F0, const Params& p) {
    const Frame F = relaunder(F0);
    constexpr int KS = 80;
    LAS unsigned char* Kl = F.lds; LAS unsigned char* Vl = F.lds + 9 * 64 * KS; LAS float* rpbl = (LAS float*)(F.lds + 2 * 9 * 64 * KS);
    bf16_t* PROJ = (bf16_t*)(p.ws + WS_PROJ);
    const int lane = F.lane, w = F.wave, n16 = lane & 15, g = lane >> 4, q4 = (lane & 15) >> 2, p4 = lane & 3;
    const int qrow = w >> 2, qb = w & 3;
    const int kc0 = qb == 0 ? 0 : qb == 1 ? 8 : qb == 2 ? 24 : 32;
    for (int unit = F.vcu; unit < NB * 64 * 32; unit += F.G) {
        const int h = unit & 31, rp = (unit >> 5) & 63, b = unit >> 11;
        const int rA = 2 * rp, r0A = min(max(rA - 4, 0), 120);
        __syncthreads();
        for (int i = F.tid; i < 9 * 64 * 4; i += NTHREADS) { const int key = i >> 2, ch = i & 3, kr = key >> 6, kcol = key & 63; const int rr = min(r0A + kr, 127);
            const bf16_t* src = PROJ + ((size_t)b * SEQ + rr * 64 + kcol) * 3072 + h * 32 + ch * 8;
            *(LAS u32x4*)(Kl + key * KS + ch * 16) = *(const u32x4*)(src + 1024); *(LAS u32x4*)(Vl + key * KS + ch * 16) = *(const u32x4*)(src + 2048); }
        for (int i = F.tid; i < 15 * 31; i += NTHREADS) rpbl[i] = p.na_rpb[(size_t)h * 465 + i];
        __syncthreads();
        const int r = rA + qrow, r0 = min(max(r - 4, 0), 120), krow0 = r0 - r0A;
        const int c = 16 * qb + n16, cstart = min(max(c - 8, 0), 48);
        const size_t tokq = (size_t)b * SEQ + r * 64 + c;
        const bf16x8 qf = *(const bf16x8*)(PROJ + tokq * 3072 + h * 32 + 8 * g);
        f32x4 sacc[16];
#pragma unroll
        for (int tau = 0; tau < 16; ++tau) { const int kr = tau >> 1, hf = tau & 1;
            const bf16x8 kf = *(const LAS bf16x8*)(Kl + ((krow0 + kr) * 64 + kc0 + 16 * hf + n16) * KS + 16 * g);
            const f32x4 z4 = {0.f, 0.f, 0.f, 0.f}; sacc[tau] = MFMA16(kf, qf, z4); }
        float mx = -3.0e38f;
#pragma unroll
        for (int tau = 0; tau < 16; ++tau) { const int kr = tau >> 1, hf = tau & 1; const int ro = r0 + kr - r + 7;
#pragma unroll
            for (int i = 0; i < 4; ++i) { const int kcol = kc0 + 16 * hf + 4 * g + i; const bool ok = (kcol >= cstart) && (kcol < cstart + 16);
                const int co = min(max(kcol - c + 15, 0), 30);
                const float s = ok ? sacc[tau][i] + rpbl[ro * 31 + co] : -3.0e38f; sacc[tau][i] = s; mx = fmaxf(mx, s); } }
        mx = fmaxf(mx, __shfl_xor(mx, 16)); mx = fmaxf(mx, __shfl_xor(mx, 32));
        float sum = 0.f;
#pragma unroll
        for (int tau = 0; tau < 16; ++tau)
#pragma unroll
            for (int i = 0; i < 4; ++i) { const float e = (sacc[tau][i] > -1.0e38f) ? fast_exp2((sacc[tau][i] - mx) * LOG2E) : 0.f; sacc[tau][i] = e; sum += e; }
        sum += __shfl_xor(sum, 16); sum += __shfl_xor(sum, 32);
        const float inv = 1.0f / sum;
        f32x4 oacc[2]; oacc[0] = (f32x4){0.f, 0.f, 0.f, 0.f}; oacc[1] = (f32x4){0.f, 0.f, 0.f, 0.f};
#pragma unroll
        for (int kr = 0; kr < 8; ++kr) {
            u32x4 pw; pw.x = cvt_pk_bf16(sacc[2 * kr][0], sacc[2 * kr][1]); pw.y = cvt_pk_bf16(sacc[2 * kr][2], sacc[2 * kr][3]); pw.z = cvt_pk_bf16(sacc[2 * kr + 1][0], sacc[2 * kr + 1][1]); pw.w = cvt_pk_bf16(sacc[2 * kr + 1][2], sacc[2 * kr + 1][3]);
            const bf16x8 pf = __builtin_bit_cast(bf16x8, pw);
            const LAS unsigned char* a0 = Vl + ((krow0 + kr) * 64 + kc0 + 4 * g + q4) * KS + 8 * p4; const LAS unsigned char* a1 = a0 + 16 * KS;
#pragma unroll
            for (int md = 0; md < 2; ++md) { const bf16x8 vf = tr_read2(a0 + 32 * md, a1 + 32 * md);
                oacc[md] = MFMA16(vf, pf, oacc[md]); }
        }
        __syncthreads();
        bf16_t* op = PROJ + tokq * 3072 + h * 32 + 4 * g;
        *(u32x2*)op = pack4(oacc[0][0] * inv, oacc[0][1] * inv, oacc[0][2] * inv, oacc[0][3] * inv);
        *(u32x2*)(op + 16) = pack4(oacc[1][0] * inv, oacc[1][1] * inv, oacc[1][2] * inv, oacc[1][3] * inv);
    }
}

#ifndef PHASE_MASK
#define PHASE_MASK 0xFFFFFFFFu
#endif
#define PH(k) ((PHASE_MASK >> (k)) & 1u)
__device__ __forceinline__ void moe_layer(const Frame& F, const Params& p, const XcdBarrier& bar, int layer, float* x) {
    if (PH(0)) moe_route_phase(F, p, layer, x);
    xcd_barrier(bar);
    if (PH(1)) moe_gather_phase(F, p, layer, x);
    xcd_barrier(bar);
    const unsigned* cnt = (const unsigned*)(p.ws + WS_CTL) + CW_MOECNT + layer * 32;
    LAS int* tab = (LAS int*)(F.lds + pg8::STAGE_BYTES);
    const int NT = moe_tile_table(F, cnt, tab);
    const int* rowtok = (const int*)(p.ws + WS_ROW); const float* rowwa = (const float*)(rowtok + MOE_ROWS); const float* rowwb = rowwa + MOE_ROWS;
    {
        MoeSched S; S.G = F.G; S.c = F.vcu; S.NP = 8; S.NT = NT; S.tile_cls = tab; S.Abase = (const char*)(p.ws + WS_H2S);
        S.wmat = (size_t)1024 * 1024 * 2; S.bntile = (size_t)256 * 1024 * 2; S.Wbase = (const char*)(p.ws + WS_W_MOE_GU) + (size_t)layer * 16 * S.wmat;
        EpiMoeGU E{(bf16_t*)(p.ws + WS_HID), rowwa, rowwb};
        if (PH(2)) pg8::gemm_phase<EpiMoeGU, MoeSched, true, 0>(F.lds, 1024, 1024, 1024, S, E);
    }
    xcd_barrier(bar);
    {
        MoeSched S; S.G = F.G; S.c = F.vcu; S.NP = 4; S.NT = NT; S.tile_cls = tab; S.Abase = (const char*)(p.ws + WS_HID);
        S.wmat = (size_t)1024 * 512 * 2; S.bntile = (size_t)256 * 512 * 2; S.Wbase = (const char*)(p.ws + WS_W_MOE_DN) + (size_t)layer * 16 * S.wmat;
        EpiMoeDown E{x, rowtok, (const float*)(p.ws + WS_MOD) + (size_t)layer * NB * 6144 + MOD_G2};
        if (PH(3)) pg8::gemm_phase<EpiMoeDown, MoeSched, true, 8>(F.lds, 1024, 1024, 512, S, E);
    }
    xcd_barrier(bar);
}
template <class Epi>
__device__ __forceinline__ void dense_gemm(const Frame& F, int N, int K, const bf16_t* A, int lda, const bf16_t* Bt, int ldb, const Epi& E) {
    pg8::DenseOrder S; S.init(T, N, F.G, (int)blockIdx.x, A, (size_t)lda, Bt, (size_t)ldb);
    pg8::gemm_phase<Epi, pg8::DenseOrder, true, 0>(F.lds, K, lda, ldb, S, E);
}
__device__ __forceinline__ void retention_layer(const Frame& F, const Params& p, const XcdBarrier& bar, int layer, int j, const float* xin, float* xout) {
    const float* modl = (const float*)(p.ws + WS_MOD) + (size_t)layer * NB * 6144;
    bf16_t* H = (bf16_t*)(p.ws + WS_H); bf16_t* PROJ = (bf16_t*)(p.ws + WS_PROJ);
    if (PH(4)) norm_phase(F, xin, p.norm_g + (size_t)(layer * 2) * D, modl, MOD_SH1, MOD_SC1, H);
    xcd_barrier(bar);
    if (PH(5)) { EpiRetIn E{PROJ}; dense_gemm(F, RET_IN, D, H, D, (const bf16_t*)(p.ws + WS_W_RET_IN) + (size_t)j * RET_IN * D, D, E); }
    xcd_barrier(bar);
#ifndef DBG_RET_STOP
#define DBG_RET_STOP 4
#endif
#ifndef REP_CHAIN
#define REP_CHAIN 1
#endif
    for (int rep = 0; rep < REP_CHAIN; ++rep) { if (DBG_RET_STOP >= 2 && PH(6)) ret_chain_phase(F, p, j); if (rep + 1 < REP_CHAIN) xcd_barrier(bar); }
    xcd_barrier(bar);
    if (DBG_RET_STOP >= 3 && PH(7)) ret_intra_phase(F, p, j);
    xcd_barrier(bar);
    if (DBG_RET_STOP >= 4 && PH(8)) { EpiResid E{xin, xout, modl + MOD_G1}; dense_gemm(F, D, 2048, PROJ + 4096, RET_IN, (const bf16_t*)(p.ws + WS_W_RET_OUT) + (size_t)j * D * 2048, 2048, E); }
    xcd_barrier(bar);
}

__global__ void __launch_bounds__(NTHREADS, 2) fwd_kernel(Params p) {
    extern __shared__ __attribute__((aligned(16))) unsigned char lds_raw[];
    Frame F;
    F.lds = (LAS unsigned char*)lds_raw;
    F.tid = threadIdx.x; F.lane = F.tid & 63; F.wave = __builtin_amdgcn_readfirstlane(F.tid >> 6);
    F.G = gridDim.x; { const int bx = blockIdx.x; F.vcu = (F.G % 8 == 0) ? (bx % 8) * (F.G / 8) + bx / 8 : bx; }
    volatile LAS unsigned* MISC = (volatile LAS unsigned*)(F.lds + MISC_OFF);
    if (F.tid < 64) MISC[F.tid] = 0u;
    __syncthreads();
    XcdBarrier bar = xcd_barrier_post((unsigned*)(p.ws + WS_CTL) + CW_BAR, MISC + 8);
    float* x = p.out;
    bf16_t* H = (bf16_t*)(p.ws + WS_H); bf16_t* PROJ = (bf16_t*)(p.ws + WS_PROJ);

#ifndef REP_P0
#define REP_P0 1
#endif
    for (int rep = 0; rep < REP_P0; ++rep) { if (PH(9)) p0_prologue(F, p); xcd_barrier(bar); }
#ifndef DBG_STAGES
#define DBG_STAGES 8
#endif

    if (DBG_STAGES >= 1) retention_layer(F, p, bar, 0, 0, p.x, x);
    if (DBG_STAGES >= 2) moe_layer(F, p, bar, 0, x);

    if (DBG_STAGES >= 3) {
        const float* modl = (const float*)(p.ws + WS_MOD) + (size_t)1 * NB * 6144;
        norm_phase(F, x, p.norm_g + (size_t)2 * D, modl, MOD_SH1, MOD_SC1, H);
        xcd_barrier(bar);
        if (PH(10)) { EpiGmIn E{PROJ, (float*)(p.ws + WS_GMSTAT)}; dense_gemm(F, GM_FFN, D, H, D, (const bf16_t*)(p.ws + WS_W_GM_IN), D, E); }
        xcd_barrier(bar);
        if (PH(11)) gm_spatial_phase(F, p);
        xcd_barrier(bar);
        if (PH(12)) { EpiResid E{x, x, modl + MOD_G1}; dense_gemm(F, D, GM_HALF, PROJ, GM_FFN, (const bf16_t*)(p.ws + WS_W_GM_OUT), GM_HALF, E); }
        xcd_barrier(bar);
    }
    if (DBG_STAGES >= 4) moe_layer(F, p, bar, 1, x);

    if (DBG_STAGES >= 5) {
        const float* modl = (const float*)(p.ws + WS_MOD) + (size_t)2 * NB * 6144;
        norm_phase(F, x, p.norm_g + (size_t)4 * D, modl, MOD_SH1, MOD_SC1, H);
        xcd_barrier(bar);
        if (PH(13)) { EpiNaIn E{PROJ}; dense_gemm(F, 3 * D, D, H, D, (const bf16_t*)(p.ws + WS_W_NA_QKV), D, E); }
        xcd_barrier(bar);
        if (PH(14)) na_attn_phase(F, p);
        xcd_barrier(bar);
        if (PH(15)) { EpiResid E{x, x, modl + MOD_G1}; dense_gemm(F, D, D, PROJ, 3 * D, (const bf16_t*)(p.ws + WS_W_NA_OUT), D, E); }
        xcd_barrier(bar);
    }
    if (DBG_STAGES >= 6) moe_layer(F, p, bar, 2, x);

    if (DBG_STAGES >= 7) retention_layer(F, p, bar, 3, 1, x, x);
    if (DBG_STAGES >= 8) moe_layer(F, p, bar, 3, x);

#ifdef DBG_DUMP
    {
        const bf16_t* src = (const bf16_t*)(p.ws + DBG_DUMP_OFF); const size_t ld = DBG_DUMP_LD;
        for (size_t i = (size_t)blockIdx.x * NTHREADS + F.tid; i < (size_t)T * D; i += (size_t)F.G * NTHREADS) { const size_t t = i >> 10, c = i & 1023; x[i] = __uint_as_float(((unsigned)src[t * ld + c]) << 16); }
    }
#else
    if (PH(16)) final_phase(F, x, p.final_g);
#endif
    if (__hip_atomic_load((unsigned*)(p.ws + WS_CTL) + CW_BAR + XB_TMO, __ATOMIC_RELAXED, __HIP_MEMORY_SCOPE_AGENT) != 0u) {
        __syncthreads();
        const float qn = __builtin_nanf("");
        for (size_t i = (size_t)blockIdx.x * NTHREADS + F.tid; i < (size_t)T * D; i += (size_t)F.G * NTHREADS) x[i] = qn;
    }
}

extern "C" void kernel_launch(void* const* d_in, const int* in_sizes, int n_in, void* d_out, int out_size, void* d_ws, size_t ws_size, hipStream_t stream) {
    static int grid = 0;
    if (grid == 0) {
        if (n_in != 22 || out_size != T * D || ws_size < WS_END) { fprintf(stderr, "kernel_launch: unexpected sizes (n_in %d, out %d, ws %zu; need ws >= %zu)\n", n_in, out_size, ws_size, (size_t)WS_END); grid = -1; return; }
        int dev = 0, cus = 0, per_cu = 0;
        if (hipGetDevice(&dev) != hipSuccess || hipDeviceGetAttribute(&cus, hipDeviceAttributeMultiprocessorCount, dev) != hipSuccess) { grid = -1; return; }
        if (hipFuncSetAttribute((const void*)fwd_kernel, hipFuncAttributeMaxDynamicSharedMemorySize, LDS_BYTES) != hipSuccess) { fprintf(stderr, "kernel_launch: hipFuncSetAttribute failed\n"); grid = -1; return; }
        if (hipOccupancyMaxActiveBlocksPerMultiprocessor(&per_cu, (const void*)fwd_kernel, NTHREADS, LDS_BYTES) != hipSuccess || per_cu < 1) fprintf(stderr, "kernel_launch: occupancy query reports %d\n", per_cu);
        (void)hipGetLastError();
        grid = cus;
    }
    if (grid < 0) return;
    if (hipMemsetAsync((char*)d_ws + WS_CTL, 0, CTL_ZERO_BYTES, stream) != hipSuccess) return;
    Params p{};
    const float** pf = (const float**)&p;
    for (int i = 0; i < 22; ++i) pf[i] = (const float*)d_in[i];
    p.out = (float*)d_out; p.ws = (unsigned char*)d_ws;
    hipLaunchKernelGGL(fwd_kernel, dim3(grid), dim3(NTHREADS), LDS_BYTES, stream, p);
}
```

```cpp
#include <hip/hip_runtime.h>
#include <cstdio>
#include <cstdint>

#define LAS __attribute__((address_space(3)))
#define GAS __attribute__((address_space(1)))
typedef unsigned short bf16_t;
typedef short bf16x8 __attribute__((ext_vector_type(8)));
typedef short s16x4 __attribute__((ext_vector_type(4)));
typedef float f32x4 __attribute__((ext_vector_type(4)));
typedef float f32x2 __attribute__((ext_vector_type(2)));
typedef float f32x16 __attribute__((ext_vector_type(16)));
typedef unsigned u32x4 __attribute__((ext_vector_type(4)));
typedef unsigned u32x2 __attribute__((ext_vector_type(2)));

constexpr int NB = 4, SEQ = 8192, T = NB * SEQ, D = 1024, DEPTH = 4;
constexpr int RET_IN = 6144, GM_FFN = 6144, GM_HALF = 3072;
constexpr int NCLS = 24;
constexpr int MOE_ROWS = T + NCLS * 256;
constexpr float EPS = 1e-6f;
constexpr float LOG2E = 1.4426950408889634f;

typedef __bf16 bf16x2_t __attribute__((ext_vector_type(2)));
__device__ __forceinline__ unsigned cvt_pk_bf16(float lo, float hi) { const f32x2 v = {lo, hi}; const bf16x2_t b = __builtin_convertvector(v, bf16x2_t); return __builtin_bit_cast(unsigned, b); }
__device__ __forceinline__ float bf_lo(unsigned w) { return __uint_as_float(w << 16); }
__device__ __forceinline__ float bf_hi(unsigned w) { return __uint_as_float(w & 0xffff0000u); }
__device__ __forceinline__ float fast_exp2(float x) { return __builtin_amdgcn_exp2f(x); }
__device__ __forceinline__ float fast_rcp(float x) { return __builtin_amdgcn_rcpf(x); }
__device__ __forceinline__ float silu_f(float x) { return x * fast_rcp(1.0f + fast_exp2(-x * LOG2E)); }

#define DBG_MISC_OFF (163840 - 256)
#ifdef DBG_AMP_MASK
#ifndef DBG_AMP_FACTOR
#define DBG_AMP_FACTOR 1
#endif
#define TCK(cls) do { if (threadIdx.x == 0) { volatile LAS unsigned long long* tk = (volatile LAS unsigned long long*)((LAS unsigned char*)0 + DBG_MISC_OFF + 128); const unsigned long long t_ = __builtin_amdgcn_s_memrealtime(); \
    if ((DBG_AMP_MASK >> (cls)) & 1) tk[1] += t_ - tk[0]; tk[0] = t_; } } while (0)
#else
#define TCK(cls) do { } while (0)
#endif
namespace pg8 {
constexpr int BM = 256, BK = 64, HALF = 128, HTB = HALF * BK * 2, STAGE_BYTES = 8 * HTB, NXCD = 8, WGM = 8;
__host__ __device__ __forceinline__ int lds_byte(int r, int c) { const int st = (r >> 4) * 2 + (c >> 5), rr = r & 15, cc = c & 31, ob = rr * 64 + cc * 2; return st * 1024 + (ob ^ (((ob >> 9) & 1) << 5)); }
__host__ __device__ __forceinline__ void stage_rc(int b, int& R, int& C) { const int st = b / 1024, sb = b % 1024, swz = sb ^ (((sb >> 9) & 1) << 5); R = (st >> 1) * 16 + swz / 64; C = (st & 1) * 32 + (swz % 64) / 2; }
__host__ __device__ __forceinline__ int perm32(int rho) { const int n = rho >> 4, i = rho & 15; return 8 * (i >> 2) + 4 * n + (i & 3); }

struct Unit { int pm, pn; const char* A; const char* B; const char* B2; int aux; const int* rt; int nvalid; };

struct DenseOrder {
    int nM, nN, nwg, G, c; const char* Abase; const char* Bbase; size_t atile, btile;
    __device__ void init(int M, int N, int G_, int c_, const void* A, size_t lda, const void* Bt, size_t ldb) { nM = M / BM; nN = N / BM; nwg = nM * nN; G = G_; c = c_; Abase = (const char*)A; Bbase = (const char*)Bt; atile = (size_t)BM * lda * 2; btile = (size_t)BM * ldb * 2; }
    __device__ bool next(int i, Unit& u) const {
        const long L = (long)i * G + c; if (L >= nwg) return false;
        int wgid = (int)L; { const int q = nwg / NXCD, r = nwg % NXCD, xcd = wgid % NXCD, off = wgid / NXCD; wgid = (xcd < r ? xcd * (q + 1) : r * (q + 1) + (xcd - r) * q) + off; }
        const int nig = WGM * nN, gid = wgid / nig, fm = gid * WGM, gsz = (nM - fm) < WGM ? (nM - fm) : WGM;
        u.pm = fm + ((wgid % nig) % gsz); u.pn = (wgid % nig) / gsz; u.A = Abase + (size_t)u.pm * atile; u.B = Bbase + (size_t)u.pn * btile; u.B2 = u.B; u.aux = 0; u.rt = nullptr; u.nvalid = 256; return true;
    }
};

__device__ __forceinline__ f32x2 gelu_pk(f32x2 v) {
    const f32x2 av = __builtin_elementwise_abs(v), d = av * 0.2316418882f + 1.0f;
    f32x2 t; t.x = __builtin_amdgcn_rcpf(d.x); t.y = __builtin_amdgcn_rcpf(d.y);
    f32x2 q = t * 0.5307027145f + (-0.7265760135f); q = q * t + 0.7107068705f; q = q * t + (-0.142248368f); q = q * t + 0.127414796f; q = q * t;
    const f32x2 s = (v * v) * (-0.72134752044f);
    f32x2 e; e.x = __builtin_amdgcn_exp2f(s.x); e.y = __builtin_amdgcn_exp2f(s.y);
    const f32x2 m = v * (q * e), r = v - m;
    f32x2 o; o.x = v.x < 0.f ? m.x : r.x; o.y = v.y < 0.f ? m.y : r.y; return o;
}

template <class Epi, class Sched, bool ALIGN_EPI, int KSW, bool GATHER = false>
__device__ __forceinline__ void gemm_phase(LAS unsigned char* lds, const int K, const int lda, const int ldb, const Sched& S, const Epi& E) {
    int tid_ = threadIdx.x; asm volatile("" : "+v"(tid_));
    const int tid = tid_, wid = __builtin_amdgcn_readfirstlane(tid >> 6), lane = tid & 63, wr = wid >> 2, wc = wid & 3, fr = lane & 15, fq = lane >> 4;
    const int nt = K / BK;
    unsigned voffA[2], voffB[2]; int rowA[2];
#pragma unroll
    for (int i = 0; i < 2; ++i) { int R, C; stage_rc(tid * 16 + i * 8192, R, C); const int Rb = Epi::PERM ? ((R & ~31) + perm32(R & 31)) : R;
        voffA[i] = GATHER ? (unsigned)C * 2u : (unsigned)(R * lda + C) * 2u; voffB[i] = (unsigned)(Rb * ldb + C) * 2u; rowA[i] = R; }
    unsigned vc0[2], vc1[2], vn0[2], vn1[2];
#define PG8_GOFF(u_, dst0, dst1) do { _Pragma("unroll") for (int _i = 0; _i < 2; ++_i) { \
        if constexpr (GATHER) { const int r0_ = rowA[_i], r1_ = rowA[_i] + HALF; \
            const int t0_ = (r0_ < (u_).nvalid) ? (u_).rt[r0_] : 0, t1_ = (r1_ < (u_).nvalid) ? (u_).rt[r1_] : 0; \
            dst0[_i] = (unsigned)t0_ * (unsigned)(lda * 2) + voffA[_i]; dst1[_i] = (unsigned)t1_ * (unsigned)(lda * 2) + voffA[_i]; } \
        else { dst0[_i] = voffA[_i]; dst1[_i] = voffA[_i] + (unsigned)hstepA; } } } while (0)
    const size_t kstep = (size_t)(BK * 2);
    const size_t hstepA = (size_t)HALF * lda * 2, hstepB = (size_t)HALF * ldb * 2;
    const unsigned ldsw = (unsigned)wid * 1024u;
    const int aoff = lds_byte(wr * 64 + fr, fq * 8), boff = lds_byte(wc * 32 + fr, fq * 8);
#define PG8_SA(b, h) (((b) * 2 + (h)) * HTB)
#define PG8_SB(b, h) ((4 + (b) * 2 + (h)) * HTB)
#define PG8_STAGE(bufoff, gbase, voff) do { _Pragma("unroll") for (int _i = 0; _i < 2; ++_i) \
        __builtin_amdgcn_global_load_lds((const unsigned*)((const char*)(gbase) + (voff)[_i]), (LAS unsigned*)(lds + (bufoff) + ldsw + _i * 8192), 16, 0, 0); } while (0)
#define PG8_LDA(dst, b, h) do { _Pragma("unroll") for (int m = 0; m < 4; ++m) _Pragma("unroll") for (int k = 0; k < 2; ++k) dst[m][k] = *(const LAS bf16x8*)(lds + PG8_SA(b, h) + aoff + m * 2048 + k * 1024); } while (0)
#define PG8_LDB(dst, b, h) do { _Pragma("unroll") for (int n = 0; n < 2; ++n) _Pragma("unroll") for (int k = 0; k < 2; ++k) dst[n][k] = *(const LAS bf16x8*)(lds + PG8_SB(b, h) + boff + n * 2048 + k * 1024); } while (0)
#define PG8_MMA(ai, bj, At, Bt) do { __builtin_amdgcn_s_setprio(1); _Pragma("unroll") for (int m = 0; m < 4; ++m) _Pragma("unroll") for (int n = 0; n < 2; ++n) _Pragma("unroll") for (int k = 0; k < 2; ++k) \
        acc[ai][bj][m][n] = __builtin_amdgcn_mfma_f32_16x16x32_bf16(Bt[n][k], At[m][k], acc[ai][bj][m][n], 0, 0, 0); __builtin_amdgcn_s_setprio(0); } while (0)
#define PG8_WAIT_V(n) asm volatile("s_waitcnt vmcnt(" #n ")" ::: "memory")
#define PG8_WAIT_L(n) asm volatile("s_waitcnt lgkmcnt(" #n ")" ::: "memory")
#define PG8_BAR __builtin_amdgcn_s_barrier()
#define PG8_SCHED __builtin_amdgcn_sched_barrier(0)
#define PG8_BPTR(u_, t_) ((KSW > 0 && (t_) >= KSW) ? (u_).B2 + (size_t)((t_) - KSW) * kstep : (u_).B + (size_t)(t_) * kstep)
    Unit cur, nxt; int ui = 0;
    if (!S.next(0, cur)) return;
    f32x4 acc[2][2][4][2];
    bf16x8 At[4][2], B0[2][2], B1[2][2];
    const char* cA = cur.A; const char* cB = cur.B;
    PG8_GOFF(cur, vc0, vc1);
    PG8_STAGE(PG8_SB(0, 0), cB, voffB); PG8_STAGE(PG8_SB(0, 1), cB + hstepB, voffB); PG8_STAGE(PG8_SA(0, 0), cA, vc0); PG8_STAGE(PG8_SA(0, 1), cA, vc1);
    if (wr == 1) PG8_BAR;
    PG8_WAIT_V(2); PG8_BAR;
    PG8_STAGE(PG8_SB(1, 0), cB + kstep, voffB); PG8_STAGE(PG8_SA(1, 0), cA + kstep, vc0); PG8_STAGE(PG8_SB(1, 1), cB + hstepB + kstep, voffB);
    PG8_WAIT_V(6); PG8_BAR;
    for (;;) {
        const bool has_next = S.next(ui + 1, nxt);
        const char* nA = has_next ? nxt.A : cA; const char* nB = has_next ? nxt.B : cB;
        if constexpr (GATHER) { if (has_next) { PG8_GOFF(nxt, vn0, vn1); } else {
#pragma unroll
            for (int _i = 0; _i < 2; ++_i) { vn0[_i] = vc0[_i]; vn1[_i] = vc1[_i]; } } }
        if constexpr (GATHER) { TCK(23); }
#pragma unroll
        for (int a = 0; a < 2; ++a)
#pragma unroll
            for (int b = 0; b < 2; ++b)
#pragma unroll
                for (int m = 0; m < 4; ++m)
#pragma unroll
                    for (int n = 0; n < 2; ++n) acc[a][b][m][n] = (f32x4){0.f, 0.f, 0.f, 0.f};

        for (int t = 0; t < nt; t += 2) {
            const bool last = (t == nt - 2);
            const char* a1 = cA + (size_t)(t + 1) * kstep;
            const char* a2 = last ? nA : cA + (size_t)(t + 2) * kstep; const char* b2 = last ? nB : PG8_BPTR(cur, t + 2);
            const char* a3 = a2 + kstep; const char* b3 = last ? nB + kstep : PG8_BPTR(cur, t + 3);
            unsigned va0[2], va1[2];
#pragma unroll
            for (int _i = 0; _i < 2; ++_i) { va0[_i] = (GATHER && last) ? vn0[_i] : vc0[_i]; va1[_i] = (GATHER && last) ? vn1[_i] : vc1[_i]; }
            PG8_LDB(B0, 0, 0); PG8_LDB(B1, 0, 1); PG8_SCHED; PG8_LDA(At, 0, 0); PG8_STAGE(PG8_SA(1, 1), a1, vc1);
            PG8_WAIT_V(8); PG8_WAIT_L(0); PG8_BAR; PG8_MMA(0, 0, At, B0); PG8_MMA(0, 1, At, B1); PG8_BAR; PG8_SCHED;
            PG8_LDA(At, 0, 1); PG8_STAGE(PG8_SB(0, 0), b2, voffB); PG8_STAGE(PG8_SB(0, 1), b2 + hstepB, voffB); PG8_STAGE(PG8_SA(0, 0), a2, va0);
            PG8_WAIT_V(8); PG8_WAIT_L(0); PG8_BAR; PG8_MMA(1, 0, At, B0); PG8_MMA(1, 1, At, B1); PG8_BAR; PG8_SCHED;
            PG8_LDB(B0, 1, 0); PG8_LDB(B1, 1, 1); PG8_SCHED; PG8_LDA(At, 1, 0); PG8_STAGE(PG8_SA(0, 1), a2, va1);
            PG8_WAIT_V(8); PG8_WAIT_L(0); PG8_BAR; PG8_MMA(0, 0, At, B0); PG8_MMA(0, 1, At, B1); PG8_BAR; PG8_SCHED;
            PG8_LDA(At, 1, 1); PG8_STAGE(PG8_SB(1, 0), b3, voffB); PG8_STAGE(PG8_SB(1, 1), b3 + hstepB, voffB); PG8_STAGE(PG8_SA(1, 0), a3, va0);
            PG8_WAIT_V(8); PG8_WAIT_L(0); PG8_BAR; PG8_MMA(1, 0, At, B0); PG8_MMA(1, 1, At, B1); PG8_BAR; PG8_SCHED;
        }
        if constexpr (ALIGN_EPI) { if (wr == 0) PG8_BAR; }
        if constexpr (GATHER) { TCK(21); }
        E(acc, cur, wr, wc, fr, fq);
        if constexpr (GATHER) { TCK(22); }
        if (!has_next) break;
        cur = nxt; cA = nA; cB = nB; ++ui;
        if constexpr (GATHER) {
#pragma unroll
            for (int _i = 0; _i < 2; ++_i) { vc0[_i] = vn0[_i]; vc1[_i] = vn1[_i]; } }
        if constexpr (ALIGN_EPI) { if (wr == 1) PG8_BAR; }
    }
    PG8_WAIT_V(0);
    if constexpr (!ALIGN_EPI) { if (wr == 0) PG8_BAR; }
    PG8_BAR;
#undef PG8_SA
#undef PG8_SB
#undef PG8_STAGE
#undef PG8_LDA
#undef PG8_LDB
#undef PG8_MMA
#undef PG8_WAIT_V
#undef PG8_WAIT_L
#undef PG8_BAR
#undef PG8_SCHED
#undef PG8_BPTR
#undef PG8_GOFF
}
}

#define XB_TMO      128
#define XB_XCNT(j)  (256  + 64 * (j))
#define XB_XSUB(j)  (1280 + 64 * (j))
#define XB_XGEN(j)  (2304 + 64 * (j))
#define XB_TOP      3328
#define XB_TOPGEN   3392
#define XCD_BAR_WORDS 3456
#define XB_SPIN_CAP (1u << 22)

__device__ __forceinline__ unsigned xb_ld(unsigned* p)              { return __hip_atomic_load(p, __ATOMIC_RELAXED, __HIP_MEMORY_SCOPE_AGENT); }
__device__ __forceinline__ unsigned xb_add(unsigned* p, unsigned v) { return __hip_atomic_fetch_add(p, v, __ATOMIC_RELAXED, __HIP_MEMORY_SCOPE_AGENT); }
__device__ __forceinline__ unsigned xb_xcc_id() { return (unsigned)__builtin_amdgcn_s_getreg((3 << 11) | 20) & 0xFu; }
#define XB_SPIN(cond, bar) do { unsigned _sp = 0; while (cond) { __builtin_amdgcn_s_sleep(1); \
    if ((++_sp & 255u) == 0u) { if (xb_ld(&(bar)[XB_TMO])) break; if (_sp > XB_SPIN_CAP) { atomicAdd(&(bar)[XB_TMO], 1u); break; } } } } while (0)

struct XcdBarrier { unsigned* bar; unsigned x; volatile LAS unsigned* st; };

__device__ __forceinline__ XcdBarrier xcd_barrier_post(unsigned* bar, volatile LAS unsigned* st) {
    XcdBarrier b; b.bar = bar; b.x = xb_xcc_id(); b.st = st;
    if (threadIdx.x == 0) (void)xb_add(&bar[XB_XCNT(b.x)], 1u);
    return b;
}
__device__ __forceinline__ void xcd_barrier_complete(unsigned* bar, unsigned x, unsigned& nloc, unsigned& nx) {
    const unsigned G = gridDim.x * gridDim.y * gridDim.z;
    unsigned sum, cnt, mine, sp = 0u;
    for (;;) {
        sum = 0u; cnt = 0u; mine = 0u;
#pragma unroll
        for (unsigned j = 0; j < 16; ++j) { const unsigned c = xb_ld(&bar[XB_XCNT(j)]); sum += c; cnt += (c > 0u) ? 1u : 0u; }
        if (sum == G) { mine = xb_ld(&bar[XB_XCNT(x)]); break; }
        __builtin_amdgcn_s_sleep(1);
        if ((++sp & 255u) == 0u) { if (xb_ld(&bar[XB_TMO])) break; if (sp > XB_SPIN_CAP) { atomicAdd(&bar[XB_TMO], 1u); break; } }
    }
    nloc = mine > 0u ? mine : 1u; nx = cnt > 0u ? cnt : 1u;
}
__device__ __forceinline__ void xcd_census(const XcdBarrier& b) {
    if (threadIdx.x == 0) { unsigned nloc, nx; xcd_barrier_complete(b.bar, b.x, nloc, nx); b.st[0] = nloc; b.st[1] = nx; }
    __syncthreads();
}
__device__ __forceinline__ void xcd_barrier(const XcdBarrier& b) {
    asm volatile("s_waitcnt vmcnt(0)" ::: "memory");
    __syncthreads();
    if (threadIdx.x == 0) {
        unsigned* bar = b.bar;
        __builtin_amdgcn_s_waitcnt(0);
        const unsigned nloc = b.st[0], nx = b.st[1];
        const unsigned old = xb_add(&bar[XB_XSUB(b.x)], 1u);
        const unsigned gen = old / nloc;
        if (old + 1u == (gen + 1u) * nloc) {
            __builtin_amdgcn_fence(__ATOMIC_RELEASE, "agent");
            asm volatile("s_waitcnt vmcnt(0)" ::: "memory");
            const unsigned og = xb_add(&bar[XB_TOP], 1u);
            const unsigned tg = og / nx;
            if (og + 1u == (tg + 1u) * nx) xb_add(&bar[XB_TOPGEN], 1u);
            else XB_SPIN(xb_ld(&bar[XB_TOPGEN]) == tg, bar);
            __builtin_amdgcn_fence(__ATOMIC_ACQUIRE, "agent");
            xb_add(&bar[XB_XGEN(b.x)], 1u);
            asm volatile("s_waitcnt vmcnt(0)" ::: "memory");
        } else {
            XB_SPIN(xb_ld(&bar[XB_XGEN(b.x)]) == gen, bar);
            __builtin_amdgcn_fence(__ATOMIC_ACQUIRE, "agent");
            asm volatile("s_waitcnt vmcnt(0)" ::: "memory");
        }
    }
    __syncthreads();
}
__device__ const float INVF_REV[128] = {1.591549367e-01f, 1.481051445e-01f, 1.378225088e-01f, 1.282537729e-01f, 1.193493679e-01f, 1.110631898e-01f, 1.033522934e-01f, 9.617675841e-02f, 8.949939907e-02f, 8.328563720e-02f, 7.750328630e-02f, 7.212239504e-02f, 6.711508334e-02f, 6.245541945e-02f, 5.811926723e-02f, 5.408416688e-02f, 5.032921210e-02f, 4.683495685e-02f, 4.358330369e-02f, 4.055740312e-02f, 3.774158657e-02f, 3.512126207e-02f, 3.268286586e-02f, 3.041376173e-02f, 2.830219641e-02f, 2.633723244e-02f, 2.450869232e-02f, 2.280710265e-02f, 2.122365311e-02f, 1.975013874e-02f, 1.837892644e-02f, 1.710291393e-02f, 1.591549441e-02f, 1.481051371e-02f, 1.378225069e-02f, 1.282537635e-02f, 1.193493698e-02f, 1.110631879e-02f, 1.033522934e-02f, 9.617676027e-03f, 8.949940093e-03f, 8.328564465e-03f, 7.750329096e-03f, 7.212239318e-03f, 6.711508147e-03f, 6.245541852e-03f, 5.811926909e-03f, 5.408416502e-03f, 5.032921210e-03f, 4.683495965e-03f, 4.358330276e-03f, 4.055740312e-03f, 3.774158424e-03f, 3.512126394e-03f, 3.268286586e-03f, 3.041376127e-03f, 2.830219688e-03f, 2.633723198e-03f, 2.450869186e-03f, 2.280710265e-03f, 2.122365171e-03f, 1.975013874e-03f, 1.837892574e-03f, 1.710291486e-03f, 1.591549488e-03f, 1.481051440e-03f, 1.378225046e-03f, 1.282537705e-03f, 1.193493721e-03f, 1.110631856e-03f, 1.033523004e-03f, 9.617675678e-04f, 8.949940093e-04f, 8.328563999e-04f, 7.750329096e-04f, 7.212239434e-04f, 6.711508031e-04f, 6.245541736e-04f, 5.811926676e-04f, 5.408416619e-04f, 5.032921326e-04f, 4.683495790e-04f, 4.358330334e-04f, 4.055740137e-04f, 3.774158540e-04f, 3.512126277e-04f, 3.268286528e-04f, 3.041376185e-04f, 2.830219455e-04f, 2.633723198e-04f, 2.450869069e-04f, 2.280710323e-04f, 2.122365258e-04f, 1.975013729e-04f, 1.837892632e-04f, 1.710291544e-04f, 1.591549371e-04f, 1.481051440e-04f, 1.378224988e-04f, 1.282537705e-04f, 1.193493736e-04f, 1.110631856e-04f, 1.033522931e-04f, 9.617675823e-05f, 8.949940093e-05f, 8.328563854e-05f, 7.750328950e-05f, 7.212239143e-05f, 6.711508468e-05f, 6.245542318e-05f, 5.811926894e-05f, 5.408416473e-05f, 5.032921035e-05f, 4.683495717e-05f, 4.358330261e-05f, 4.055740283e-05f, 3.774158540e-05f, 3.512126204e-05f, 3.268286673e-05f, 3.041376112e-05f, 2.830219637e-05f, 2.633723125e-05f, 2.450869215e-05f, 2.280710396e-05f, 2.122365186e-05f, 1.975013765e-05f, 1.837892523e-05f, 1.710291508e-05f};

constexpr size_t MiB = (size_t)1 << 20;
constexpr size_t WS_CTL = 0, CTL_ZERO_BYTES = 1 * MiB;
constexpr int CW_BAR = 4096, CW_MOECNT = 16384, CW_MOEHEAD = 16384 + 1024;
constexpr int CW_CONVQ = 24576;
constexpr size_t WS_MOD = 1 * MiB;
constexpr size_t WS_TOK = 2 * MiB;
constexpr size_t WS_ROW = 3 * MiB;
constexpr size_t WS_W_RET_IN = 4 * MiB, WS_W_RET_OUT = 28 * MiB, WS_W_GM_IN = 36 * MiB, WS_W_GM_OUT = 48 * MiB, WS_W_NA_QKV = 54 * MiB, WS_W_NA_OUT = 60 * MiB;
constexpr size_t WS_W_MOE_GU = 64 * MiB, WS_W_MOE_DN = 192 * MiB;
constexpr size_t WS_PROJ = 256 * MiB;
constexpr size_t WS_REGB = 640 * MiB;
constexpr size_t WS_CROSSF = WS_REGB, WS_CROSSB = WS_REGB + 128 * MiB;
constexpr size_t WS_H = WS_REGB;
constexpr size_t WS_GMSTAT = WS_REGB + 64 * MiB;
constexpr size_t WS_H2 = WS_REGB;
constexpr size_t WS_HID = WS_REGB + 80 * MiB;
constexpr size_t WS_ROWTOK = WS_REGB + 160 * MiB;
constexpr size_t WS_END = 896 * MiB;
constexpr int MOD_SH1 = 0, MOD_SC1 = 1024, MOD_G1 = 2048, MOD_SH2 = 3072, MOD_SC2 = 4096, MOD_G2 = 5120;

constexpr int NWAVES = 8, NTHREADS = 512;
constexpr int LDS_BYTES = 163840;
constexpr int MISC_OFF = LDS_BYTES - 256;

struct Params {
    const float *x, *c, *norm_g, *final_g, *w_ada, *b_ada, *ret_w_in, *ret_decay, *ret_w_out, *gm_w_in, *gm_ln_g, *gm_ln_b, *gm_w_s, *gm_b_s, *gm_w_out,
                *na_w_qkv, *na_rpb, *na_w_out, *router_w, *router_b, *moe_gu, *moe_dn;
    float* out; unsigned char* ws;
};

typedef const __attribute__((address_space(4))) Params KParams;
typedef KParams& KP;
__device__ __forceinline__ KParams* kparams() { KParams* q = (KParams*)__builtin_amdgcn_kernarg_segment_ptr(); asm volatile("" : "+s"(q)); return q; }

struct Frame {
    LAS unsigned char* lds; int tid, lane, wave, vcu, G;
};
__device__ __forceinline__ Frame relaunder(const Frame& F0) { Frame F = F0; int t = threadIdx.x; asm volatile("" : "+v"(t)); F.tid = t; F.lane = t & 63; F.wave = __builtin_amdgcn_readfirstlane(t >> 6); return F; }

template <int CTRL> __device__ __forceinline__ float dpp_mov(float v) { return __builtin_bit_cast(float, __builtin_amdgcn_update_dpp(0, __builtin_bit_cast(int, v), CTRL, 0xf, 0xf, true)); }
__device__ __forceinline__ float wave_sum(float v) {
    v += dpp_mov<0xB1>(v);
    v += dpp_mov<0x4E>(v);
    v += dpp_mov<0x141>(v);
    v += dpp_mov<0x140>(v);
    const int iv = __builtin_bit_cast(int, v);
    const float r0 = __builtin_bit_cast(float, __builtin_amdgcn_readlane(iv, 0)), r1 = __builtin_bit_cast(float, __builtin_amdgcn_readlane(iv, 16));
    const float r2 = __builtin_bit_cast(float, __builtin_amdgcn_readlane(iv, 32)), r3 = __builtin_bit_cast(float, __builtin_amdgcn_readlane(iv, 48));
    return (r0 + r1) + (r2 + r3);
}
#define LDS_WAIT() asm volatile("s_waitcnt lgkmcnt(0)" ::: "memory")

template <int ROWS, int COLS>
__device__ __forceinline__ void load_tile(LAS unsigned char* dst, int pitch, const bf16_t* src, size_t ld, int tid_) {
    constexpr int CPR = COLS / 8, TOTAL = ROWS * CPR;
    int tid = tid_; asm volatile("" : "+v"(tid));
#pragma unroll
    for (int i0 = 0; i0 < TOTAL; i0 += NTHREADS) { const int i = i0 + tid; if (TOTAL % NTHREADS == 0 || i < TOTAL) { const int r = i / CPR, c = i % CPR;
        const u32x4 v = *(const u32x4*)(src + (size_t)r * ld + c * 8); *(LAS u32x4*)(dst + r * pitch + c * 16) = v; } }
}
__device__ __forceinline__ bf16x8 tr_read2(const LAS unsigned char* a0, const LAS unsigned char* a1) {
    const s16x4 lo = __builtin_amdgcn_ds_read_tr16_b64_v4i16((LAS s16x4*)a0), hi = __builtin_amdgcn_ds_read_tr16_b64_v4i16((LAS s16x4*)a1);
    return __builtin_shufflevector(lo, hi, 0, 1, 2, 3, 4, 5, 6, 7);
}
#define MFMA32(a, b, c) __builtin_amdgcn_mfma_f32_32x32x16_bf16((a), (b), (c), 0, 0, 0)
#define MFMA16(a, b, c) __builtin_amdgcn_mfma_f32_16x16x32_bf16((a), (b), (c), 0, 0, 0)
__device__ __forceinline__ f32x16 zero16() { f32x16 z; for (int i = 0; i < 16; ++i) z[i] = 0.f; return z; }

__device__ __forceinline__ void p0_transpose_item(const float* W, int K, int N, bf16_t* WT, int k0, int n0, int drow0, LAS float* scr, int lane) {
#pragma unroll 16
    for (int i = 0; i < 32; ++i) { const int kk = 2 * i + (lane >> 5); scr[kk * 33 + (lane & 31)] = W[(size_t)(k0 + kk) * N + n0 + (lane & 31)]; }
    LDS_WAIT(); asm volatile("" ::: "memory");
    const int c = lane & 7;
#pragma unroll
    for (int j = 0; j < 4; ++j) { const int n = (lane >> 3) + 8 * j; const LAS float* s = scr + (8 * c) * 33 + n;
        u32x4 o; o.x = cvt_pk_bf16(s[0 * 33], s[1 * 33]); o.y = cvt_pk_bf16(s[2 * 33], s[3 * 33]); o.z = cvt_pk_bf16(s[4 * 33], s[5 * 33]); o.w = cvt_pk_bf16(s[6 * 33], s[7 * 33]);
        *(u32x4*)(WT + (size_t)(drow0 + n) * K + k0 + 8 * c) = o; }
    LDS_WAIT(); asm volatile("" ::: "memory");
}
constexpr int CQ_RET_IN = 16 * 192, CQ_RET_OUT = 32 * 32, CQ_MOE_GU = 16 * 16 * 32, CQ_MOE_DN = 16 * 8 * 32, CQ_MOE = CQ_MOE_GU + CQ_MOE_DN;
constexpr int CQ_GM_IN = 16 * 192, CQ_GM_OUT = 48 * 32, CQ_NA_QKV = 16 * 96, CQ_NA_OUT = 16 * 32;
constexpr int CQ_E_RET0 = CQ_RET_IN + CQ_RET_OUT, CQ_E_MOE0 = CQ_E_RET0 + CQ_MOE, CQ_E_GM = CQ_E_MOE0 + CQ_GM_IN + CQ_GM_OUT, CQ_E_MOE1 = CQ_E_GM + CQ_MOE;
constexpr int CQ_E_NA = CQ_E_MOE1 + CQ_NA_QKV + CQ_NA_OUT, CQ_E_MOE2 = CQ_E_NA + CQ_MOE, CQ_E_RET1 = CQ_E_MOE2 + CQ_RET_IN + CQ_RET_OUT, CQ_E_MOE3 = CQ_E_RET1 + CQ_MOE, CQ_TOTAL = CQ_E_MOE3;
#ifndef CQ_STEAL
#define CQ_STEAL 1
#endif
#define CQ_JOB(SRC, DST, K_, N_, GU_) { constexpr int nnb_ = (N_) / 32, per_ = ((K_) / 64) * nnb_; const int mat_ = r / per_, rr_ = r % per_; kb = rr_ / nnb_; nb = rr_ % nnb_; K = (K_); N = (N_); gu = (GU_); \
    src = (SRC) + (size_t)mat_ * (K_) * (N_); dst = (bf16_t*)(p.ws + (DST)) + (size_t)mat_ * (K_) * (N_); }
__device__ __forceinline__ void conv_item(KP p, int it  , LAS float* scr, int lane) {
    const float* src; bf16_t* dst; int K, N, kb, nb, r = it; bool gu;
    int layer = -1;
    if (r < CQ_E_RET0) { if (r < CQ_RET_IN) CQ_JOB(p.ret_w_in, WS_W_RET_IN, D, RET_IN, false) else { r -= CQ_RET_IN; CQ_JOB(p.ret_w_out, WS_W_RET_OUT, 2048, D, false) } }
    else if (r < CQ_E_MOE0) { r -= CQ_E_RET0; layer = 0; }
    else if (r < CQ_E_GM) { r -= CQ_E_MOE0; if (r < CQ_GM_IN) CQ_JOB(p.gm_w_in, WS_W_GM_IN, D, GM_FFN, false) else { r -= CQ_GM_IN; CQ_JOB(p.gm_w_out, WS_W_GM_OUT, GM_HALF, D, false) } }
    else if (r < CQ_E_MOE1) { r -= CQ_E_GM; layer = 1; }
    else if (r < CQ_E_NA) { r -= CQ_E_MOE1; if (r < CQ_NA_QKV) CQ_JOB(p.na_w_qkv, WS_W_NA_QKV, D, 3 * D, false) else { r -= CQ_NA_QKV; CQ_JOB(p.na_w_out, WS_W_NA_OUT, D, D, false) } }
    else if (r < CQ_E_MOE2) { r -= CQ_E_NA; layer = 2; }
    else if (r < CQ_E_RET1) { r -= CQ_E_MOE2; if (r < CQ_RET_IN) CQ_JOB(p.ret_w_in + (size_t)D * RET_IN, WS_W_RET_IN + (size_t)D * RET_IN * 2, D, RET_IN, false) else { r -= CQ_RET_IN; CQ_JOB(p.ret_w_out + (size_t)2048 * D, WS_W_RET_OUT + (size_t)2048 * D * 2, 2048, D, false) } }
    else { r -= CQ_E_RET1; layer = 3; }
    if (layer >= 0) {
        if (r < CQ_MOE_GU) CQ_JOB(p.moe_gu + (size_t)layer * 16 * 1024 * 1024, WS_W_MOE_GU + (size_t)layer * 16 * 1024 * 1024 * 2, D, 1024, true)
        else { r -= CQ_MOE_GU; CQ_JOB(p.moe_dn + (size_t)layer * 16 * 512 * 1024, WS_W_MOE_DN + (size_t)layer * 16 * 512 * 1024 * 2, 512, D, false) }
    }
    const int n0 = nb * 32;
    int drow0 = n0;
    if (gu) drow0 = (n0 < 512) ? ((n0 >> 7) * 256 + (n0 & 127)) : (((n0 - 512) >> 7) * 256 + 128 + ((n0 - 512) & 127));
    p0_transpose_item(src, K, N, dst, kb * 64, n0, drow0, scr, lane);
}
constexpr int CQ_BATCH = 4;
struct ConvWave { unsigned* ctr; int q, nq; volatile LAS unsigned* st; unsigned hw, lo, hi; };
__device__ __forceinline__ ConvWave conv_wave(unsigned* ctl, LAS unsigned char* lds, int wave) {
    ConvWave w; const int G = gridDim.x; w.nq = (G % 8 == 0) ? 8 : 1; w.q = (G % 8 == 0) ? (int)(blockIdx.x & 7) : 0; w.ctr = ctl + CW_CONVQ + 64 * w.q;
    w.st = (volatile LAS unsigned*)(lds + MISC_OFF);
    w.hw = __builtin_amdgcn_readfirstlane(w.st[16 + wave]); w.lo = __builtin_amdgcn_readfirstlane(w.st[40 + 2 * wave]); w.hi = __builtin_amdgcn_readfirstlane(w.st[41 + 2 * wave]);
    return w;
}
__device__ __forceinline__ void conv_wave_save(const ConvWave& w, int wave) { w.st[16 + wave] = w.hw; w.st[40 + 2 * wave] = w.lo; w.st[41 + 2 * wave] = w.hi; }
__device__ __forceinline__ void conv_claim(ConvWave& w, int lane) {
    int c = 0; if (lane == 0) c = (int)__hip_atomic_fetch_add(w.ctr, 1u, __ATOMIC_RELAXED, __HIP_MEMORY_SCOPE_AGENT);
    c = __builtin_amdgcn_readfirstlane(c);
    const unsigned s = (unsigned)(c * w.nq + w.q) * CQ_BATCH;
    w.hw = s + (unsigned)(w.nq * CQ_BATCH);
    if (s < (unsigned)CQ_TOTAL) { w.lo = s; w.hi = s + CQ_BATCH; }
}
__device__ __forceinline__ void conv_drain(const Frame& F0, KP p, int E) {
    __syncthreads();
    const Frame F = relaunder(F0);
    LAS float* scr = (LAS float*)(F.lds + F.wave * 16384);
    ConvWave w = conv_wave((unsigned*)(p.ws + WS_CTL), F.lds, F.wave);
    for (;;) {
        while (w.lo < w.hi) { conv_item(p, (int)w.lo, scr, F.lane); ++w.lo; }
        if (w.hw >= (unsigned)E) break;
        conv_claim(w, F.lane);
    }
    conv_wave_save(w, F.wave);
}
__device__ __forceinline__ void xcd_barrier_steal(const XcdBarrier& b) {
    asm volatile("s_waitcnt vmcnt(0)" ::: "memory");
    if (threadIdx.x == 0) b.st[2] = 0u;
    __syncthreads();
    int t = threadIdx.x; asm volatile("" : "+v"(t));
    if (t == 0) {
        unsigned* bar = b.bar;
        __builtin_amdgcn_s_waitcnt(0);
        const unsigned nloc = b.st[0], nx = b.st[1];
        const unsigned old = xb_add(&bar[XB_XSUB(b.x)], 1u);
        const unsigned gen = old / nloc;
        if (old + 1u == (gen + 1u) * nloc) {
            __builtin_amdgcn_fence(__ATOMIC_RELEASE, "agent");
            asm volatile("s_waitcnt vmcnt(0)" ::: "memory");
            const unsigned og = xb_add(&bar[XB_TOP], 1u);
            const unsigned tg = og / nx;
            if (og + 1u == (tg + 1u) * nx) xb_add(&bar[XB_TOPGEN], 1u);
            else XB_SPIN(xb_ld(&bar[XB_TOPGEN]) == tg, bar);
            __builtin_amdgcn_fence(__ATOMIC_ACQUIRE, "agent");
            xb_add(&bar[XB_XGEN(b.x)], 1u);
            asm volatile("s_waitcnt vmcnt(0)" ::: "memory");
        } else {
            XB_SPIN(xb_ld(&bar[XB_XGEN(b.x)]) == gen, bar);
            __builtin_amdgcn_fence(__ATOMIC_ACQUIRE, "agent");
            asm volatile("s_waitcnt vmcnt(0)" ::: "memory");
        }
        b.st[2] = 1u;
    } else if (CQ_STEAL && t >= 64) {
        const int wave = __builtin_amdgcn_readfirstlane(t >> 6), lane = t & 63;
        LAS unsigned char* lds = (LAS unsigned char*)b.st - (MISC_OFF + 32);
        if (((volatile LAS unsigned*)(lds + MISC_OFF))[16 + wave] < (unsigned)CQ_TOTAL || ((volatile LAS unsigned*)(lds + MISC_OFF))[40 + 2 * wave] < ((volatile LAS unsigned*)(lds + MISC_OFF))[41 + 2 * wave]) {
            KP p = *kparams();
            LAS float* scr = (LAS float*)(lds + wave * 16384);
            ConvWave w = conv_wave(b.bar - CW_BAR, lds, wave);
            while (b.st[2] == 0u) {
                if (w.lo < w.hi) { conv_item(p, (int)w.lo, scr, lane); ++w.lo; continue; }
                if (w.hw >= (unsigned)CQ_TOTAL) break;
                conv_claim(w, lane);
            }
            conv_wave_save(w, wave);
        }
    }
    __syncthreads();
}
__device__ __forceinline__ void p0_prologue(const Frame& F0, KP p) {
    const Frame F = relaunder(F0);
    {
        LAS float* cact = (LAS float*)F.lds;
        LAS float* part = (LAS float*)(F.lds + 16384);
        float* MOD = (float*)(p.ws + WS_MOD);
        bool loaded = false;
        for (int task = blockIdx.x; task < DEPTH * 48; task += F.G) {
            if (!loaded) { for (int i = F.tid; i < NB * D; i += NTHREADS) { const float v = p.c[i]; cact[i] = silu_f(v); } loaded = true; __syncthreads(); }
            const int layer = task / 48, cg = task % 48, ksub = F.lane >> 5, cl = F.lane & 31, c0 = cg * 128 + 4 * cl;
            f32x4 a[NB];
#pragma unroll
            for (int b = 0; b < NB; ++b) a[b] = (f32x4){0.f, 0.f, 0.f, 0.f};
            const unsigned voff = (unsigned)(ksub * 6144 + c0) * 4u;
            const float* wrow = p.w_ada + ((size_t)layer * D + F.wave * 128) * 6144;
#define MOD_LD(u) asm volatile("global_load_dwordx4 %0, %1, %2" : "=&v"(wv[u]) : "v"(voff), "s"(wrow + (size_t)(2 * (i0 + (u))) * 6144) : "memory")
#define MOD_FMA(u) { asm volatile("s_waitcnt vmcnt(%1)" : "+v"(wv[u]) : "n"(15 - (u)) : "memory"); \
                _Pragma("unroll") for (int b = 0; b < NB; ++b) { const float cv = cact[b * D + F.wave * 128 + 2 * (i0 + (u)) + ksub]; a[b] = a[b] + wv[u] * cv; } }
            for (int i0 = 0; i0 < 64; i0 += 16) {
                f32x4 wv[16];
                MOD_LD(0); MOD_LD(1); MOD_LD(2); MOD_LD(3); MOD_LD(4); MOD_LD(5); MOD_LD(6); MOD_LD(7); MOD_LD(8); MOD_LD(9); MOD_LD(10); MOD_LD(11); MOD_LD(12); MOD_LD(13); MOD_LD(14); MOD_LD(15);
                MOD_FMA(0) MOD_FMA(1) MOD_FMA(2) MOD_FMA(3) MOD_FMA(4) MOD_FMA(5) MOD_FMA(6) MOD_FMA(7) MOD_FMA(8) MOD_FMA(9) MOD_FMA(10) MOD_FMA(11) MOD_FMA(12) MOD_FMA(13) MOD_FMA(14) MOD_FMA(15)
            }
#undef MOD_LD
#undef MOD_FMA
#pragma unroll
            for (int b = 0; b < NB; ++b) {
#pragma unroll
                for (int e = 0; e < 4; ++e) a[b][e] += __shfl_xor(a[b][e], 32);
                if (ksub == 0) *(LAS f32x4*)(part + (F.wave * NB + b) * 128 + 4 * cl) = a[b]; }
            __syncthreads();
            { const int b = F.tid >> 7, col = F.tid & 127; float s = 0.f;
#pragma unroll
              for (int w = 0; w < NWAVES; ++w) s += part[(w * NB + b) * 128 + col];
              MOD[((size_t)layer * NB + b) * 6144 + cg * 128 + col] = s + p.b_ada[(size_t)layer * 6144 + cg * 128 + col]; }
            __syncthreads();
        }
        __syncthreads();
    }
}

__device__ __forceinline__ void norm_phase(const Frame& F0, const float* xin, const float* ng, const float* modl  , int sh_off, int sc_off, bf16_t* H) {
    const Frame F = relaunder(F0);
    const int gw = F.vcu * NWAVES + F.wave, NGW = F.G * NWAVES;
    for (int rb = gw; rb < T / 16; rb += NGW) {
        const int row0 = rb * 16, b = row0 >> 13;
        f32x4 gs[4], sh[4];
#pragma unroll
        for (int j = 0; j < 4; ++j) { const int c = 4 * F.lane + 256 * j; const f32x4 g = *(const f32x4*)(ng + c), sc = *(const f32x4*)(modl + (size_t)b * 6144 + sc_off + c);
            gs[j] = g * (sc + 1.0f); sh[j] = *(const f32x4*)(modl + (size_t)b * 6144 + sh_off + c); }
        for (int r = 0; r < 16; ++r) {
            const float* xr = xin + (size_t)(row0 + r) * D + 4 * F.lane;
            f32x4 v[4]; float ss = 0.f;
#pragma unroll
            for (int j = 0; j < 4; ++j) { v[j] = *(const f32x4*)(xr + 256 * j); ss += (v[j].x * v[j].x + v[j].y * v[j].y) + (v[j].z * v[j].z + v[j].w * v[j].w); }
            const float rstd = 1.0f / sqrtf(wave_sum(ss) * (1.0f / D) + EPS);
            bf16_t* hr = H + (size_t)(row0 + r) * D + 4 * F.lane;
#pragma unroll
            for (int j = 0; j < 4; ++j) { const f32x4 o = v[j] * rstd * gs[j] + sh[j]; u32x2 w; w.x = cvt_pk_bf16(o.x, o.y); w.y = cvt_pk_bf16(o.z, o.w); *(u32x2*)(hr + 256 * j) = w; }
        }
    }
}
__device__ __forceinline__ void final_phase(const Frame& F0, float* x, const float* fg) {
    const Frame F = relaunder(F0);
    const int gw = F.vcu * NWAVES + F.wave, NGW = F.G * NWAVES;
    f32x4 g[4];
#pragma unroll
    for (int j = 0; j < 4; ++j) g[j] = *(const f32x4*)(fg + 4 * F.lane + 256 * j);
    for (int row = gw; row < T; row += NGW) {
        float* xr = x + (size_t)row * D + 4 * F.lane;
        f32x4 v[4]; float ss = 0.f;
#pragma unroll
        for (int j = 0; j < 4; ++j) { v[j] = *(const f32x4*)(xr + 256 * j); ss += (v[j].x * v[j].x + v[j].y * v[j].y) + (v[j].z * v[j].z + v[j].w * v[j].w); }
        const float rstd = 1.0f / sqrtf(wave_sum(ss) * (1.0f / D) + EPS);
#pragma unroll
        for (int j = 0; j < 4; ++j) *(f32x4*)(xr + 256 * j) = v[j] * rstd * g[j];
    }
}

typedef f32x4 AccT[2][2][4][2];
__device__ __forceinline__ void st8(bf16_t* p, const f32x4& v0, const f32x4& v1) {
    u32x4 w; w.x = cvt_pk_bf16(v0.x, v0.y); w.y = cvt_pk_bf16(v0.z, v0.w); w.z = cvt_pk_bf16(v1.x, v1.y); w.w = cvt_pk_bf16(v1.z, v1.w); *(u32x4*)p = w;
}
struct EpiRetIn {
    static constexpr bool PERM = true;
    bf16_t* O;
    __device__ __forceinline__ void operator()(const AccT& acc, const pg8::Unit& u, int wr, int wc, int fr, int fq) const {
        const int row0 = u.pm * 256 + wr * 64 + fr, col0 = u.pn * 256 + wc * 32 + 8 * fq;
        if (u.pn < 8) {
            const float osc = (u.pn >= 4) ? 0.0625f : 1.0f;
            float invf[8];
#pragma unroll
            for (int q = 0; q < 8; ++q) invf[q] = INVF_REV[wc * 32 + 8 * fq + q];
#pragma unroll
            for (int ai = 0; ai < 2; ++ai)
#pragma unroll
                for (int m = 0; m < 4; ++m) { const int row = row0 + ai * 128 + m * 16; const float pos = (float)(row & (SEQ - 1));
                    f32x4 o1[2], o2[2];
#pragma unroll
                    for (int n = 0; n < 2; ++n)
#pragma unroll
                        for (int j = 0; j < 4; ++j) { float rev = pos * invf[n * 4 + j]; rev -= floorf(rev);
                            const float sn = __builtin_amdgcn_sinf(rev), cs = __builtin_amdgcn_cosf(rev);
                            const float x1 = acc[ai][0][m][n][j], x2 = acc[ai][1][m][n][j];
                            o1[n][j] = (x1 * cs - x2 * sn) * osc; o2[n][j] = (x1 * sn + x2 * cs) * osc; }
                    bf16_t* rp = O + (size_t)row * RET_IN + col0;
                    st8(rp, o1[0], o1[1]); st8(rp + 128, o2[0], o2[1]); }
        } else {
#pragma unroll
            for (int ai = 0; ai < 2; ++ai)
#pragma unroll
                for (int m = 0; m < 4; ++m) { bf16_t* rp = O + (size_t)(row0 + ai * 128 + m * 16) * RET_IN + col0;
                    st8(rp, acc[ai][0][m][0], acc[ai][0][m][1]); st8(rp + 128, acc[ai][1][m][0], acc[ai][1][m][1]); }
        }
    }
};
struct EpiGmIn {
    static constexpr bool PERM = true;
    bf16_t* O; float* stat;
    __device__ __forceinline__ void operator()(const AccT& acc, const pg8::Unit& u, int wr, int wc, int fr, int fq) const {
        const int row0 = u.pm * 256 + wr * 64 + fr, col0 = u.pn * 256 + wc * 32 + 8 * fq;
        const bool vhalf = u.pn >= 12;
#pragma unroll
        for (int ai = 0; ai < 2; ++ai)
#pragma unroll
            for (int m = 0; m < 4; ++m) { const int row = row0 + ai * 128 + m * 16; bf16_t* rp = O + (size_t)row * GM_FFN + col0; float s1 = 0.f, s2 = 0.f;
#pragma unroll
                for (int bj = 0; bj < 2; ++bj) { f32x4 v[2];
#pragma unroll
                    for (int n = 0; n < 2; ++n) { const f32x4 a = acc[ai][bj][m][n]; const f32x2 g0 = pg8::gelu_pk((f32x2){a.x, a.y}), g1 = pg8::gelu_pk((f32x2){a.z, a.w}); v[n] = (f32x4){g0.x, g0.y, g1.x, g1.y};
                        s1 += (g0.x + g0.y) + (g1.x + g1.y); s2 += (g0.x * g0.x + g0.y * g0.y) + (g1.x * g1.x + g1.y * g1.y); }
                    st8(rp + bj * 128, v[0], v[1]); }
                if (vhalf) { s1 += __shfl_xor(s1, 16); s1 += __shfl_xor(s1, 32); s2 += __shfl_xor(s2, 16); s2 += __shfl_xor(s2, 32);
                    if (fq == 0) *(f32x2*)(stat + ((size_t)((u.pn - 12) * 4 + wc) * T + row) * 2) = (f32x2){s1, s2}; } }
    }
};
struct EpiNaIn {
    static constexpr bool PERM = true;
    bf16_t* O;
    __device__ __forceinline__ void operator()(const AccT& acc, const pg8::Unit& u, int wr, int wc, int fr, int fq) const {
        const int row0 = u.pm * 256 + wr * 64 + fr, col0 = u.pn * 256 + wc * 32 + 8 * fq;
        const float sc = (u.pn < 4) ? 0.17677669529663687f * LOG2E : 1.0f;
#pragma unroll
        for (int ai = 0; ai < 2; ++ai)
#pragma unroll
            for (int m = 0; m < 4; ++m) { bf16_t* rp = O + (size_t)(row0 + ai * 128 + m * 16) * 3072 + col0;
                st8(rp, acc[ai][0][m][0] * sc, acc[ai][0][m][1] * sc); st8(rp + 128, acc[ai][1][m][0] * sc, acc[ai][1][m][1] * sc); }
    }
};
struct EpiResid {
    static constexpr bool PERM = false;
    const float* xin; float* xout; const float* g;
    __device__ __forceinline__ void operator()(const AccT& acc, const pg8::Unit& u, int wr, int wc, int fr, int fq) const {
        const int row0 = u.pm * 256 + wr * 64 + fr, col0 = u.pn * 256 + wc * 32 + 4 * fq, b = (u.pm * 256) >> 13;
        f32x4 gv[2][2];
#pragma unroll
        for (int bj = 0; bj < 2; ++bj)
#pragma unroll
            for (int n = 0; n < 2; ++n) gv[bj][n] = *(const f32x4*)(g + (size_t)b * 6144 + col0 + bj * 128 + n * 16);
#pragma unroll
        for (int ai = 0; ai < 2; ++ai)
#pragma unroll
            for (int m = 0; m < 4; ++m) { const size_t off = (size_t)(row0 + ai * 128 + m * 16) * D + col0;
#pragma unroll
                for (int bj = 0; bj < 2; ++bj)
#pragma unroll
                    for (int n = 0; n < 2; ++n) { const f32x4 xv = *(const f32x4*)(xin + off + bj * 128 + n * 16); *(f32x4*)(xout + off + bj * 128 + n * 16) = xv + gv[bj][n] * acc[ai][bj][m][n]; } }
    }
};
struct EpiMoeGU {
    static constexpr bool PERM = true;
    bf16_t* hid; const float* tok_wa; const float* tok_wb;
    __device__ __forceinline__ void operator()(const AccT& acc, const pg8::Unit& u, int wr, int wc, int fr, int fq) const {
        const int r0 = wr * 64 + fr, col0 = (u.pn >> 2) * 512 + (u.pn & 3) * 128 + wc * 32 + 8 * fq;
        const float* wsel = (u.pn < 4) ? tok_wa : tok_wb;
#pragma unroll
        for (int ai = 0; ai < 2; ++ai)
#pragma unroll
            for (int m = 0; m < 4; ++m) { const int r = r0 + ai * 128 + m * 16;
                if (r < u.nvalid) { const int tok = u.rt[r]; const float w = wsel[tok]; f32x4 v[2];
#pragma unroll
                    for (int n = 0; n < 2; ++n)
#pragma unroll
                        for (int j = 0; j < 4; ++j) v[n][j] = w * silu_f(acc[ai][0][m][n][j]) * acc[ai][1][m][n][j];
                    st8(hid + (size_t)tok * 1024 + col0, v[0], v[1]); } }
    }
};
struct EpiMoeDown {
    static constexpr bool PERM = false;
    float* x; const float* g;
    __device__ __forceinline__ void operator()(const AccT& acc, const pg8::Unit& u, int wr, int wc, int fr, int fq) const {
        const int r0 = wr * 64 + fr, col0 = u.pn * 256 + wc * 32 + 4 * fq;
#pragma unroll
        for (int ai = 0; ai < 2; ++ai)
#pragma unroll
            for (int m = 0; m < 4; ++m) { const int r = r0 + ai * 128 + m * 16;
                if (r < u.nvalid) { const int tok = u.rt[r]; const size_t off = (size_t)tok * D + col0; const float* gp = g + (size_t)(tok >> 13) * 6144 + col0;
#pragma unroll
                    for (int bj = 0; bj < 2; ++bj)
#pragma unroll
                        for (int n = 0; n < 2; ++n) { const f32x4 xv = *(const f32x4*)(x + off + bj * 128 + n * 16), gv = *(const f32x4*)(gp + bj * 128 + n * 16);
                            *(f32x4*)(x + off + bj * 128 + n * 16) = xv + gv * acc[ai][bj][m][n]; } } }
    }
};

__device__ __forceinline__ float second_of4_sum(float a, float b, float c, float d) {
    const float hi1 = fmaxf(a, b), lo1 = fminf(a, b), hi2 = fmaxf(c, d), lo2 = fminf(c, d);
    return fmaxf(hi1, hi2) + fmaxf(fminf(hi1, hi2), fmaxf(lo1, lo2));
}
__device__ __forceinline__ void moe_route_phase(const Frame& F0, KP p, int layer, const float* x) {
    const Frame F = relaunder(F0);
    constexpr int BP = 1028;
    LAS float* BpT = (LAS float*)F.lds;
    LAS float* cb = (LAS float*)(F.lds + 16 * BP * 4);
    LAS int* tcls = (LAS int*)(F.lds + 16 * BP * 4 + 128);
    LAS int* cbase = (LAS int*)(F.lds + 16 * BP * 4 + 128 + 512);
    LAS float* Lt = (LAS float*)(F.lds + 16 * BP * 4 + 1024) + F.wave * 256;
    const float* modl = (const float*)(p.ws + WS_MOD) + (size_t)layer * NB * 6144;
    const float* ng = p.norm_g + (size_t)(layer * 2 + 1) * D;
    unsigned* cnt = (unsigned*)(p.ws + WS_CTL) + CW_MOECNT + layer * 32;
    float* tok_wa = (float*)(p.ws + WS_TOK); float* tok_wb = tok_wa + T;
    int* rowtok = (int*)(p.ws + WS_ROWTOK);
    bf16_t* h2 = (bf16_t*)(p.ws + WS_H2);
    const int lane = F.lane, n16 = lane & 15, g = lane >> 4;
    int built_b = -1;
    for (int chunk = blockIdx.x; chunk < T / 128; chunk += F.G) {
        const int b = chunk >> 6;
        if (b != built_b) {
            for (int k = F.tid; k < D; k += NTHREADS) { const float gs = ng[k] * (1.0f + modl[(size_t)b * 6144 + MOD_SC2 + k]);
#pragma unroll
                for (int q = 0; q < 4; ++q) { const f32x4 r = *(const f32x4*)(p.router_w + (size_t)k * 16 + 4 * q);
                    BpT[(4 * q + 0) * BP + k] = gs * r.x; BpT[(4 * q + 1) * BP + k] = gs * r.y; BpT[(4 * q + 2) * BP + k] = gs * r.z; BpT[(4 * q + 3) * BP + k] = gs * r.w; } }
#pragma unroll
            for (int q = 0; q < 2; ++q) { const int e = 2 * F.wave + q; float sacc = 0.f;
                for (int k = F.lane; k < D; k += 64) sacc += modl[(size_t)b * 6144 + MOD_SH2 + k] * p.router_w[(size_t)k * 16 + e];
                sacc = wave_sum(sacc); if (F.lane == 0) cb[e] = sacc; }
            built_b = b;
        }
        __syncthreads();
        const int tokb = chunk * 128 + F.wave * 16;
        f32x4 acc0 = {0.f, 0.f, 0.f, 0.f}, acc1 = {0.f, 0.f, 0.f, 0.f}; float ss = 0.f;
        {
            const float* xp = x + (size_t)(tokb + n16) * D + 4 * g; const LAS float* bp = BpT + n16 * BP + 4 * g;
#pragma unroll 8
            for (int m = 0; m < 64; ++m) { const f32x4 xa = *(const f32x4*)(xp + 16 * m); const f32x4 wb = *(const LAS f32x4*)(bp + 16 * m);
                ss += (xa.x * xa.x + xa.y * xa.y) + (xa.z * xa.z + xa.w * xa.w);
                acc0 = __builtin_amdgcn_mfma_f32_16x16x4f32(xa.x, wb.x, acc0, 0, 0, 0); acc1 = __builtin_amdgcn_mfma_f32_16x16x4f32(xa.y, wb.y, acc1, 0, 0, 0);
                acc0 = __builtin_amdgcn_mfma_f32_16x16x4f32(xa.z, wb.z, acc0, 0, 0, 0); acc1 = __builtin_amdgcn_mfma_f32_16x16x4f32(xa.w, wb.w, acc1, 0, 0, 0); }
        }
        ss += __shfl_xor(ss, 16); ss += __shfl_xor(ss, 32);
        const float rstd_l = 1.0f / sqrtf(ss * (1.0f / D) + EPS);
        {
            const f32x4 acc = acc0 + acc1; const float cbe = cb[n16];
#pragma unroll
            for (int i = 0; i < 4; ++i) { const float rs = __shfl(rstd_l, 4 * g + i); Lt[(4 * g + i) * 16 + n16] = rs * acc[i] + cbe; }
        }
        LDS_WAIT();
        if (lane < 16) {
            float sc[16], bi[16];
#pragma unroll
            for (int q = 0; q < 4; ++q) { const f32x4 lv = *(const LAS f32x4*)(Lt + lane * 16 + 4 * q);
#pragma unroll
                for (int jj = 0; jj < 4; ++jj) { const int e = 4 * q + jj; sc[e] = 1.0f / (1.0f + __expf(-lv[jj])); bi[e] = sc[e] + p.router_b[e]; } }
            float gsum[4];
#pragma unroll
            for (int gg = 0; gg < 4; ++gg) gsum[gg] = second_of4_sum(bi[4 * gg], bi[4 * gg + 1], bi[4 * gg + 2], bi[4 * gg + 3]);
            int grp = 0; float best = gsum[0];
#pragma unroll
            for (int gg = 1; gg < 4; ++gg) if (gsum[gg] > best) { best = gsum[gg]; grp = gg; }
            float vb[4], vs[4];
#pragma unroll
            for (int q = 0; q < 4; ++q) { vb[q] = grp == 0 ? bi[q] : grp == 1 ? bi[4 + q] : grp == 2 ? bi[8 + q] : bi[12 + q]; vs[q] = grp == 0 ? sc[q] : grp == 1 ? sc[4 + q] : grp == 2 ? sc[8 + q] : sc[12 + q]; }
            int i1 = 0; float m1 = vb[0];
#pragma unroll
            for (int q = 1; q < 4; ++q) if (vb[q] > m1) { m1 = vb[q]; i1 = q; }
            int i2 = -1; float m2 = -3.0e38f;
#pragma unroll
            for (int q = 0; q < 4; ++q) if (q != i1 && vb[q] > m2) { m2 = vb[q]; i2 = q; }
            const int la = i1 < i2 ? i1 : i2, lb = i1 < i2 ? i2 : i1;
            const float sa = la == 0 ? vs[0] : la == 1 ? vs[1] : vs[2], sb = lb == 1 ? vs[1] : lb == 2 ? vs[2] : vs[3];
            const float inv = 1.0f / (sa + sb);
            const int pi = la == 0 ? lb - 1 : la == 1 ? lb + 1 : 5;
            tcls[F.wave * 16 + lane] = grp * 6 + pi; tok_wa[tokb + lane] = sa * inv; tok_wb[tokb + lane] = sb * inv;
        }
        {
            f32x4 gs4[4], sh4[4];
#pragma unroll
            for (int j = 0; j < 4; ++j) { const int cc = 4 * lane + 256 * j; const f32x4 gv = *(const f32x4*)(ng + cc), scv = *(const f32x4*)(modl + (size_t)b * 6144 + MOD_SC2 + cc);
                gs4[j] = gv * (scv + 1.0f); sh4[j] = *(const f32x4*)(modl + (size_t)b * 6144 + MOD_SH2 + cc); }
            f32x4 vn[4];
#pragma unroll
            for (int j = 0; j < 4; ++j) vn[j] = *(const f32x4*)(x + (size_t)tokb * D + 4 * lane + 256 * j);
            for (int r = 0; r < 16; ++r) {
                f32x4 v[4];
#pragma unroll
                for (int j = 0; j < 4; ++j) v[j] = vn[j];
                { const int nt = (r < 15) ? tokb + r + 1 : tokb + r;
#pragma unroll
                  for (int j = 0; j < 4; ++j) vn[j] = *(const f32x4*)(x + (size_t)nt * D + 4 * lane + 256 * j); }
                const float rstd = __builtin_bit_cast(float, __builtin_amdgcn_readlane(__builtin_bit_cast(int, rstd_l), r));
                bf16_t* hr = h2 + (size_t)(tokb + r) * D + 4 * lane;
#pragma unroll
                for (int j = 0; j < 4; ++j) { const f32x4 o = v[j] * rstd * gs4[j] + sh4[j]; u32x2 wq; wq.x = cvt_pk_bf16(o.x, o.y); wq.y = cvt_pk_bf16(o.z, o.w); *(u32x2*)(hr + 256 * j) = wq; }
            }
        }
        __syncthreads();
        if (F.tid < NCLS) { int n = 0; for (int jj = 0; jj < 128; ++jj) n += (tcls[jj] == F.tid) ? 1 : 0; cbase[F.tid] = n ? (int)atomicAdd(cnt + F.tid, (unsigned)n) : 0; }
        __syncthreads();
        if (F.tid < 128) { const int cls = tcls[F.tid]; int rank = 0; for (int jj = 0; jj < F.tid; ++jj) rank += (tcls[jj] == cls) ? 1 : 0;
            rowtok[(size_t)cls * T + cbase[cls] + rank] = chunk * 128 + F.tid; }
        __syncthreads();
    }
}
struct MoeSched {
    int G, c, NP, NT; const LAS int* tile_cls; const char* Abase; const char* Wbase; size_t wmat, bntile; const int* rowtok; const unsigned* cnt; unsigned* head; volatile LAS int* slot;
    __device__ bool next(int i, pg8::Unit& u) const {
        const int q = (G % 8 == 0) ? c / (G / 8) : 0, nq = (G % 8 == 0) ? 8 : 1;
        if (threadIdx.x == 0) slot[i & 1] = (int)__hip_atomic_fetch_add(head + 64 * q, 1u, __ATOMIC_RELAXED, __HIP_MEMORY_SCOPE_AGENT);
        asm volatile("s_waitcnt vmcnt(0) lgkmcnt(0)" ::: "memory"); __builtin_amdgcn_s_barrier(); asm volatile("" ::: "memory");
        const int Lq = __builtin_amdgcn_readfirstlane(slot[i & 1]);
        const int rt = q + nq * (Lq / NP), pn = Lq % NP; if (rt >= NT) return false;
        const int tc = tile_cls[rt], cls = tc >> 8, kblk = tc & 255, grp = cls / 6, pi = cls % 6;
        const int la = pi < 3 ? 0 : (pi < 5 ? 1 : 2), lb = pi < 3 ? pi + 1 : (pi < 5 ? pi - 1 : 3);
        const int ea = grp * 4 + la, eb = grp * 4 + lb;
        u.pm = rt; u.pn = pn; u.aux = 0; u.A = Abase; u.rt = rowtok + (size_t)cls * T + kblk * 256;
        const int left = (int)__hip_atomic_load(cnt + cls, __ATOMIC_RELAXED, __HIP_MEMORY_SCOPE_AGENT) - kblk * 256; u.nvalid = left < 256 ? left : 256;
        if (NP == 8) { const int e = pn < 4 ? ea : eb; u.B = Wbase + (size_t)e * wmat + (size_t)(pn & 3) * bntile; u.B2 = u.B; }
        else { u.B = Wbase + (size_t)ea * wmat + (size_t)pn * bntile; u.B2 = Wbase + (size_t)eb * wmat + (size_t)pn * bntile; }
        return true;
    }
};
__device__ __forceinline__ int moe_tile_table(const Frame& F, const unsigned* cnt, LAS int* tab) {
    if (threadIdx.x == 0) { int rt = 0; for (int c = 0; c < NCLS; ++c) { const int n = (int)__hip_atomic_load(cnt + c, __ATOMIC_RELAXED, __HIP_MEMORY_SCOPE_AGENT); const int nt = (n + 255) >> 8; for (int k = 0; k < nt; ++k) tab[rt++] = (c << 8) | k; } tab[255] = rt; }
    __syncthreads();
    return tab[255];
}

#define TR2(lo, hi, base, OFF0, OFF1) asm volatile("ds_read_b64_tr_b16 %0, %2 offset:%3\n\tds_read_b64_tr_b16 %1, %2 offset:%4" : "=&v"(lo), "=&v"(hi) : "v"(base), "i"(OFF0), "i"(OFF1) : "memory")
#define RD128(dst, base, OFF) asm volatile("ds_read_b128 %0, %1 offset:%2" : "=&v"(dst) : "v"(base), "i"(OFF) : "memory")
#define LGKM_WAIT6(N, a, b, c, d, e, f) asm volatile("s_waitcnt lgkmcnt(" #N ")" : "+v"(a), "+v"(b), "+v"(c), "+v"(d), "+v"(e), "+v"(f) :: "memory")
#define LGKM_WAIT4(N, a, b, c, d) asm volatile("s_waitcnt lgkmcnt(" #N ")" : "+v"(a), "+v"(b), "+v"(c), "+v"(d) :: "memory")
#define GLD128(dst, ptr) asm volatile("global_load_dwordx4 %0, %1, off" : "=&v"(dst) : "v"(ptr) : "memory")
#define RAW_BARRIER() do { asm volatile("s_waitcnt lgkmcnt(0)" ::: "memory"); __builtin_amdgcn_s_barrier(); asm volatile("" ::: "memory"); } while (0)
__device__ __forceinline__ float log2_gamma(const float* decay_logit) {
    const float xv = *decay_logit; return -log1pf(__expf(-xv)) * LOG2E;
}
__device__ __forceinline__ u32x2 pack4(float a, float b, float c, float d) { u32x2 w; w.x = cvt_pk_bf16(a, b); w.y = cvt_pk_bf16(c, d); return w; }
__device__ __forceinline__ void ret_chain_phase(const Frame& F0, KP p, int j) {
    const Frame F = relaunder(F0);
    constexpr int PQ = 528, KSLOT = 32768, VSLOT = 8192;
    LAS unsigned char* bufK = F.lds; LAS unsigned char* bufV = F.lds + 3 * KSLOT; LAS unsigned char* ST = bufV + 3 * VSLOT;
    const bf16_t* PROJ = (const bf16_t*)(p.ws + WS_PROJ);
    const int lane = F.lane, w = F.wave, l32 = lane & 31, hh = lane >> 5, blk = (lane >> 4) & 1, q4 = (lane & 15) >> 2, p4 = lane & 3, n16 = lane & 15, g = lane >> 4;
    unsigned kdoff[4];
#pragma unroll
    for (int i = 0; i < 4; ++i) { const int row = 2 * (4 * w + i) + (lane >> 5); kdoff[i] = (unsigned)(row * RET_IN + (((lane & 31) ^ (4 * (row & 3))) * 8)) * 2u; }
    const int vrow = F.tid >> 3, vchk = F.tid & 7;
    const unsigned vdoff = (unsigned)(vrow * RET_IN + vchk * 8) * 2u;
    const int vlds = vrow * 128 + ((vchk ^ (4 * ((vrow >> 1) & 1))) * 16);
    const int kch = (4 * w + 2 * blk + (p4 >> 1)) ^ (4 * q4);
    const int aKoff = (8 * hh + q4) * 512 + kch * 16 + (p4 & 1) * 8;
    const int vch0 = (2 * blk + (p4 >> 1)) ^ (4 * ((q4 >> 1) & 1)), vch1 = (4 + 2 * blk + (p4 >> 1)) ^ (4 * ((q4 >> 1) & 1));
    const int aV0off = (8 * hh + q4) * 128 + vch0 * 16 + (p4 & 1) * 8, aV1off = (8 * hh + q4) * 128 + vch1 * 16 + (p4 & 1) * 8;
    for (int chain = F.vcu; chain < 256; chain += F.G) {
        const int b = chain >> 6, h = (chain >> 4) & 3, dir = (chain >> 3) & 1, sl = chain & 7;
        const float lg2 = log2_gamma(p.ret_decay + (size_t)j * 8 + dir * 4 + h);
        bf16_t* CROSS = (bf16_t*)(p.ws + (dir ? WS_CROSSB : WS_CROSSF));
        const float dec = fast_exp2(lg2 * 128.0f);
        f32x16 sacc[2]; sacc[0] = zero16(); sacc[1] = zero16();
        bf16x8 qa[8], qb[8];
        const int c16 = 16 * w + n16;
        const size_t qoff = (size_t)c16 * RET_IN + h * 256 + 8 * g;
        const float xi = dir ? fast_exp2(lg2 * (float)(128 - c16)) : fast_exp2(lg2 * (float)(c16 + 1));
        const float zs = dir ? lg2 : -lg2, z0 = dir ? 0.f : lg2 * 127.0f;
        const float zv0 = fast_exp2(zs * (float)vrow + z0), zv1 = fast_exp2(zs * (float)(64 + vrow) + z0);
        u32x4 vA, vB;
        const bf16_t* kbase = PROJ + (size_t)b * SEQ * RET_IN + 1024 + h * 256;
        const bf16_t* vbase = PROJ + (size_t)b * SEQ * RET_IN + 2048 + h * 512 + sl * 64;
#define CH_ISSUE(hs_) do { const int st_ = (hs_) >> 1, hf_ = (hs_) & 1, n_ = dir ? 63 - st_ : st_, sl3_ = (hs_) % 3; \
            const char* kg_ = (const char*)(kbase + ((size_t)n_ * 128 + 64 * hf_) * RET_IN); const char* vg_ = (const char*)(vbase + ((size_t)n_ * 128 + 64 * hf_) * RET_IN); \
            _Pragma("unroll") for (int i_ = 0; i_ < 4; ++i_) __builtin_amdgcn_global_load_lds((const unsigned*)(kg_ + kdoff[i_]), (LAS unsigned*)(bufK + sl3_ * KSLOT + (4 * w + i_) * 1024), 16, 0, 0); (void)vg_; } while (0)
#define CH_LOADV(hs_, VR) do { const int st_ = (hs_) >> 1, hf_ = (hs_) & 1, n_ = dir ? 63 - st_ : st_; \
            GLD128(VR, (const char*)(vbase + ((size_t)n_ * 128 + 64 * hf_) * RET_IN) + vdoff); } while (0)
#define CH_WRITEV(hs_, VR) do { const float z_ = ((hs_) & 1) ? zv1 : zv0; u32x4 o_; \
            o_.x = cvt_pk_bf16(bf_lo(VR.x) * z_, bf_hi(VR.x) * z_); o_.y = cvt_pk_bf16(bf_lo(VR.y) * z_, bf_hi(VR.y) * z_); o_.z = cvt_pk_bf16(bf_lo(VR.z) * z_, bf_hi(VR.z) * z_); o_.w = cvt_pk_bf16(bf_lo(VR.w) * z_, bf_hi(VR.w) * z_); \
            *(LAS u32x4*)(bufV + ((hs_) % 3) * VSLOT + vlds) = o_; } while (0)
#define CH_RDK(ks_, kl, kh, al, ah, bl, bh) do { TR2(kl, kh, aKb, (16 * (ks_)) * 512, (16 * (ks_) + 4) * 512); TR2(al, ah, aV0b, (16 * (ks_)) * 128, (16 * (ks_) + 4) * 128); TR2(bl, bh, aV1b, (16 * (ks_)) * 128, (16 * (ks_) + 4) * 128); } while (0)
#define CH_MM(kl, kh, al, ah, bl, bh) do { const bf16x8 ka_ = __builtin_shufflevector(kl, kh, 0, 1, 2, 3, 4, 5, 6, 7); \
            sacc[0] = MFMA32(ka_, __builtin_shufflevector(al, ah, 0, 1, 2, 3, 4, 5, 6, 7), sacc[0]); sacc[1] = MFMA32(ka_, __builtin_shufflevector(bl, bh, 0, 1, 2, 3, 4, 5, 6, 7), sacc[1]); } while (0)
#define CH_UPDATE(hs_) do { const int sl3_ = (hs_) % 3; \
            const unsigned aKb = (unsigned)(uintptr_t)(bufK + sl3_ * KSLOT + aKoff), aV0b = (unsigned)(uintptr_t)(bufV + sl3_ * VSLOT + aV0off), aV1b = (unsigned)(uintptr_t)(bufV + sl3_ * VSLOT + aV1off); \
            s16x4 k0l, k0h, a0l, a0h, b0l, b0h, k1l, k1h, a1l, a1h, b1l, b1h; \
            CH_RDK(0, k0l, k0h, a0l, a0h, b0l, b0h); CH_RDK(1, k1l, k1h, a1l, a1h, b1l, b1h); \
            LGKM_WAIT6(6, k0l, k0h, a0l, a0h, b0l, b0h); CH_MM(k0l, k0h, a0l, a0h, b0l, b0h); \
            CH_RDK(2, k0l, k0h, a0l, a0h, b0l, b0h); \
            LGKM_WAIT6(6, k1l, k1h, a1l, a1h, b1l, b1h); CH_MM(k1l, k1h, a1l, a1h, b1l, b1h); \
            CH_RDK(3, k1l, k1h, a1l, a1h, b1l, b1h); \
            LGKM_WAIT6(6, k0l, k0h, a0l, a0h, b0l, b0h); CH_MM(k0l, k0h, a0l, a0h, b0l, b0h); \
            LGKM_WAIT6(0, k1l, k1h, a1l, a1h, b1l, b1h); CH_MM(k1l, k1h, a1l, a1h, b1l, b1h); } while (0)
        __syncthreads();
        for (int i = F.tid; i < 64 * PQ / 16; i += NTHREADS) *(LAS u32x4*)(ST + i * 16) = (u32x4){0u, 0u, 0u, 0u};
        {
            const int n = dir ? 63 : 0; const bf16_t* base = PROJ + ((size_t)b * SEQ + (size_t)n * 128) * RET_IN;
#pragma unroll
            for (int ks = 0; ks < 8; ++ks) GLD128(qa[ks], base + qoff + 32 * ks);
            CH_LOADV(0, vA); CH_ISSUE(0);
            asm volatile("s_waitcnt vmcnt(4)" : "+v"(vA) :: "memory");
            CH_WRITEV(0, vA); CH_LOADV(1, vB); CH_LOADV(2, vA); CH_ISSUE(1);
        }
        asm volatile("s_waitcnt vmcnt(4)" : "+v"(vB) :: "memory");
        asm volatile("" : "+v"(vA));
#pragma unroll
        for (int ks = 0; ks < 8; ++ks) asm volatile("" : "+v"(qa[ks]));
        __syncthreads();
#define CHAIN_STEP(step_, QC, QN) do { \
            const int n = dir ? 63 - (step_) : (step_); \
            const size_t tok0 = (size_t)b * SEQ + (size_t)n * 128; \
              \
            CH_WRITEV(2 * (step_) + 1, vB); \
            if ((step_) < 63) { CH_LOADV(2 * (step_) + 3, vB); CH_ISSUE(2 * (step_) + 2); } \
            {     \
                const int nn = ((step_) < 63) ? (dir ? n - 1 : n + 1) : n; const bf16_t* nbase = PROJ + ((size_t)b * SEQ + (size_t)nn * 128) * RET_IN; \
                _Pragma("unroll") for (int ks = 0; ks < 8; ++ks) GLD128(QN[ks], nbase + qoff + 32 * ks); \
                f32x4 acc[4]; \
                _Pragma("unroll") for (int e4 = 0; e4 < 4; ++e4) acc[e4] = (f32x4){0.f, 0.f, 0.f, 0.f}; \
                const unsigned stb = (unsigned)(uintptr_t)(ST + n16 * PQ + 16 * g); bf16x8 sf[2][4]; \
                _Pragma("unroll") for (int e4 = 0; e4 < 4; ++e4) RD128(sf[0][e4], stb, (16 * e4) * PQ); \
                _Pragma("unroll") for (int ks = 0; ks < 8; ++ks) { \
                    if (ks < 7) { _Pragma("unroll") for (int e4 = 0; e4 < 4; ++e4) RD128(sf[(ks + 1) & 1][e4], stb, (16 * e4) * PQ + 64 * (ks + 1)); \
                                  LGKM_WAIT4(4, sf[ks & 1][0], sf[ks & 1][1], sf[ks & 1][2], sf[ks & 1][3]); } \
                    else { LGKM_WAIT4(0, sf[ks & 1][0], sf[ks & 1][1], sf[ks & 1][2], sf[ks & 1][3]); } \
                    _Pragma("unroll") for (int e4 = 0; e4 < 4; ++e4) acc[e4] = MFMA16(sf[ks & 1][e4], QC[ks], acc[e4]); } \
                bf16_t* op = CROSS + (tok0 + c16) * 2048 + h * 512 + sl * 64 + 4 * g; \
                _Pragma("unroll") for (int e4 = 0; e4 < 4; ++e4) *(u32x2*)(op + 16 * e4) = pack4(acc[e4][0] * xi, acc[e4][1] * xi, acc[e4][2] * xi, acc[e4][3] * xi); \
            } \
            _Pragma("unroll") for (int i = 0; i < 16; ++i) { sacc[0][i] *= dec; sacc[1][i] *= dec; } \
            CH_UPDATE(2 * (step_)); \
              \
            if ((step_) < 63) asm volatile("s_waitcnt vmcnt(17)" : "+v"(vA) :: "memory"); else asm volatile("s_waitcnt vmcnt(12)" : "+v"(vA) :: "memory");        \
            RAW_BARRIER();         \
              \
            if ((step_) < 63) { CH_WRITEV(2 * (step_) + 2, vA); if ((step_) < 62) CH_LOADV(2 * (step_) + 4, vA); CH_ISSUE(2 * (step_) + 3); } \
            CH_UPDATE(2 * (step_) + 1); \
            _Pragma("unroll") for (int e2 = 0; e2 < 2; ++e2) \
                _Pragma("unroll") for (int g4 = 0; g4 < 4; ++g4) *(LAS u32x2*)(ST + (32 * e2 + l32) * PQ + (32 * w + 8 * g4 + 4 * hh) * 2) = pack4(sacc[e2][4 * g4], sacc[e2][4 * g4 + 1], sacc[e2][4 * g4 + 2], sacc[e2][4 * g4 + 3]); \
              \
            if ((step_) < 63) asm volatile("s_waitcnt vmcnt(5)" : "+v"(vB) :: "memory"); else asm volatile("s_waitcnt vmcnt(0)" : "+v"(vB) :: "memory");        \
            _Pragma("unroll") for (int ks = 0; ks < 8; ++ks) asm volatile("" : "+v"(QN[ks])); \
            RAW_BARRIER();         \
        } while (0)
        for (int step = 0; step < 64; step += 2) { CHAIN_STEP(step, qa, qb); CHAIN_STEP(step + 1, qb, qa); }
#undef CHAIN_STEP
#undef CH_ISSUE
#undef CH_UPDATE
#undef CH_RDK
#undef CH_MM
#undef CH_WRITEV
#undef CH_LOADV
    }
}
__device__ __forceinline__ void ret_intra_phase(const Frame& F0, KP p, int j) {
    const Frame F = relaunder(F0);
    constexpr int PQ = 528, PP = 272, PX = 1040;
    LAS unsigned char* R0 = F.lds; LAS unsigned char* R1 = F.lds + 128 * PQ; LAS unsigned char* X = F.lds; LAS float* red = (LAS float*)(F.lds + 128 * PX);
    bf16_t* PROJ = (bf16_t*)(p.ws + WS_PROJ);
    const bf16_t* CF = (const bf16_t*)(p.ws + WS_CROSSF); const bf16_t* CB = (const bf16_t*)(p.ws + WS_CROSSB);
    const int lane0 = F.lane, w = F.wave;
    for (int unit = F.vcu; unit < 1024; unit += F.G) {
        int lane = lane0; asm volatile("" : "+v"(lane));
        const int l32 = lane & 31, hh = lane >> 5, blk = (lane >> 4) & 1, q4 = (lane & 15) >> 2, p4 = lane & 3;
        const int b = unit >> 8, h = (unit >> 6) & 3, n = unit & 63;
        const float lgf = log2_gamma(p.ret_decay + (size_t)j * 8 + h), lgb = log2_gamma(p.ret_decay + (size_t)j * 8 + 4 + h);
        const size_t tok0 = (size_t)b * SEQ + (size_t)n * 128;
        const int tr0 = F.tid >> 5, tc = F.tid & 31;
        const bf16_t* vsrc = PROJ + (tok0 + tr0) * RET_IN + 2048 + h * 512 + tc * 8;
        __syncthreads();
        load_tile<128, 256>(R0, PQ, PROJ + tok0 * RET_IN + h * 256, RET_IN, F.tid);
        load_tile<128, 256>(R1, PQ, PROJ + tok0 * RET_IN + 1024 + h * 256, RET_IN, F.tid);
        u32x4 vreg[8];
#pragma unroll
        for (int i = 0; i < 8; ++i) vreg[i] = *(const u32x4*)(vsrc + (size_t)(16 * i) * RET_IN);
        __syncthreads();
        {
            const int mt = w >> 1;
            f32x16 pacc[2]; pacc[0] = zero16(); pacc[1] = zero16();
#pragma unroll
            for (int ks = 0; ks < 16; ++ks) {
                const bf16x8 a = *(const LAS bf16x8*)(R1 + (32 * mt + l32) * PQ + (16 * ks + 8 * hh) * 2);
#pragma unroll
                for (int ci = 0; ci < 2; ++ci) { const int ct = 2 * (w & 1) + ci;
                    const bf16x8 bq = *(const LAS bf16x8*)(R0 + (32 * ct + l32) * PQ + (16 * ks + 8 * hh) * 2);
                    pacc[ci] = MFMA32(a, bq, pacc[ci]); }
            }
#pragma unroll
            for (int ci = 0; ci < 2; ++ci) { const int c = 32 * (2 * (w & 1) + ci) + l32;
#pragma unroll
                for (int i = 0; i < 16; ++i) { const int m = 32 * mt + (i & 3) + 8 * (i >> 2) + 4 * hh; const int dl = c - m;
                    pacc[ci][i] *= (dl >= 0) ? fast_exp2(lgf * (float)dl) : fast_exp2(lgb * (float)(-dl)); } }
            __syncthreads();
#pragma unroll
            for (int ci = 0; ci < 2; ++ci) { const int c = 32 * (2 * (w & 1) + ci) + l32;
#pragma unroll
                for (int g4 = 0; g4 < 4; ++g4) *(LAS u32x2*)(R0 + c * PP + (32 * mt + 8 * g4 + 4 * hh) * 2) = pack4(pacc[ci][4 * g4], pacc[ci][4 * g4 + 1], pacc[ci][4 * g4 + 2], pacc[ci][4 * g4 + 3]); }
        }
        f32x16 oacc[2][4];
#pragma unroll
        for (int hf = 0; hf < 2; ++hf)
#pragma unroll
            for (int e = 0; e < 4; ++e) oacc[hf][e] = zero16();
        const int ct = w & 3, eg = w >> 2;
#pragma unroll
        for (int hf = 0; hf < 2; ++hf) {
            if (hf == 1) __syncthreads();
#pragma unroll
            for (int i = 0; i < 8; ++i) *(LAS u32x4*)(R1 + (tr0 + 16 * i) * PQ + tc * 16) = vreg[i];
            if (hf == 0) {
#pragma unroll
                for (int i = 0; i < 8; ++i) vreg[i] = *(const u32x4*)(vsrc + 256 + (size_t)(16 * i) * RET_IN);
            }
            __syncthreads();
            const LAS unsigned char* aV = R1 + (8 * hh + q4) * PQ + 32 * blk + 8 * p4;
#pragma unroll
            for (int ks = 0; ks < 8; ++ks) {
                const bf16x8 pb = *(const LAS bf16x8*)(R0 + (32 * ct + l32) * PP + (16 * ks + 8 * hh) * 2);
#pragma unroll
                for (int e = 0; e < 4; ++e) { const int et = 4 * eg + e;
                    const bf16x8 va = tr_read2(aV + (16 * ks) * PQ + 64 * et, aV + (16 * ks + 4) * PQ + 64 * et);
                    oacc[hf][e] = MFMA32(va, pb, oacc[hf][e]); }
            }
        }
        __syncthreads();
        {
            const int xr0 = F.tid >> 6, xc = F.tid & 63;
            const bf16_t* fp = CF + (tok0 + xr0) * 2048 + h * 512 + xc * 8; const bf16_t* bp = CB + (tok0 + xr0) * 2048 + h * 512 + xc * 8;
#pragma unroll
            for (int qtr = 0; qtr < 4; ++qtr) {
                u32x4 fv[4], bv[4];
#pragma unroll
                for (int i = 0; i < 4; ++i) { fv[i] = *(const u32x4*)(fp + (size_t)(8 * (4 * qtr + i)) * 2048); bv[i] = *(const u32x4*)(bp + (size_t)(8 * (4 * qtr + i)) * 2048); }
#pragma unroll
                for (int i = 0; i < 4; ++i) { u32x4 o;
                    o.x = cvt_pk_bf16(bf_lo(fv[i].x) + bf_lo(bv[i].x), bf_hi(fv[i].x) + bf_hi(bv[i].x)); o.y = cvt_pk_bf16(bf_lo(fv[i].y) + bf_lo(bv[i].y), bf_hi(fv[i].y) + bf_hi(bv[i].y));
                    o.z = cvt_pk_bf16(bf_lo(fv[i].z) + bf_lo(bv[i].z), bf_hi(fv[i].z) + bf_hi(bv[i].z)); o.w = cvt_pk_bf16(bf_lo(fv[i].w) + bf_lo(bv[i].w), bf_hi(fv[i].w) + bf_hi(bv[i].w));
                    *(LAS u32x4*)(X + (xr0 + 8 * (4 * qtr + i)) * PX + xc * 16) = o; }
                asm volatile("" ::: "memory");
            }
        }
        __syncthreads();
        LAS unsigned char* xrow = X + (32 * ct + l32) * PX;
        float ss = 0.f;
#pragma unroll
        for (int hf = 0; hf < 2; ++hf)
#pragma unroll
            for (int e = 0; e < 4; ++e)
#pragma unroll
                for (int g4 = 0; g4 < 4; ++g4) { const int e0 = hf * 256 + 32 * (4 * eg + e) + 8 * g4 + 4 * hh;
                    const u32x2 cx = *(const LAS u32x2*)(xrow + e0 * 2);
                    const float o0 = oacc[hf][e][4 * g4] + bf_lo(cx.x), o1 = oacc[hf][e][4 * g4 + 1] + bf_hi(cx.x), o2 = oacc[hf][e][4 * g4 + 2] + bf_lo(cx.y), o3 = oacc[hf][e][4 * g4 + 3] + bf_hi(cx.y);
                    ss += (o0 * o0 + o1 * o1) + (o2 * o2 + o3 * o3);
                    *(LAS u32x2*)(xrow + e0 * 2) = pack4(o0, o1, o2, o3); }
        ss += __shfl_xor(ss, 32);
        if (hh == 0) red[(32 * ct + l32) * 2 + eg] = ss;
        __syncthreads();
        {
            const int xr0 = F.tid >> 6, xc = F.tid & 63;
            bf16_t* gp = PROJ + (tok0 + xr0) * RET_IN + 4096 + h * 512 + xc * 8;
#pragma unroll
            for (int half = 0; half < 2; ++half) {
                u32x4 gv[8];
#pragma unroll
                for (int i = 0; i < 8; ++i) gv[i] = *(const u32x4*)(gp + (size_t)(8 * (8 * half + i)) * RET_IN);
#pragma unroll
                for (int i = 0; i < 8; ++i) { const int r = xr0 + 8 * (8 * half + i);
                    const float rstd = 1.0f / sqrtf((red[r * 2] + red[r * 2 + 1]) * (1.0f / 512.0f) + EPS);
                    const u32x4 ov = *(const LAS u32x4*)(X + r * PX + xc * 16); u32x4 o;
                    o.x = cvt_pk_bf16(bf_lo(ov.x) * rstd * silu_f(bf_lo(gv[i].x)), bf_hi(ov.x) * rstd * silu_f(bf_hi(gv[i].x))); o.y = cvt_pk_bf16(bf_lo(ov.y) * rstd * silu_f(bf_lo(gv[i].y)), bf_hi(ov.y) * rstd * silu_f(bf_hi(gv[i].y)));
                    o.z = cvt_pk_bf16(bf_lo(ov.z) * rstd * silu_f(bf_lo(gv[i].z)), bf_hi(ov.z) * rstd * silu_f(bf_hi(gv[i].z))); o.w = cvt_pk_bf16(bf_lo(ov.w) * rstd * silu_f(bf_lo(gv[i].w)), bf_hi(ov.w) * rstd * silu_f(bf_hi(gv[i].w)));
                    *(u32x4*)(gp + (size_t)(8 * (8 * half + i)) * RET_IN) = o; }
            }
        }
    }
}

__device__ __forceinline__ void gm_spatial_phase(const Frame& F0, KP p) {
    const Frame F = relaunder(F0);
    constexpr int PW = 272, PVV = 528;
    LAS unsigned char* Wp = F.lds; LAS unsigned char* Vt = F.lds + 128 * PW;
    LAS float* mu = (LAS float*)(F.lds + 128 * PW + 128 * PVV); LAS float* rs = mu + 128; LAS float* corr = rs + 128; LAS float* rsw = corr + 128;
    bf16_t* PROJ = (bf16_t*)(p.ws + WS_PROJ);
    const float* stat = (const float*)(p.ws + WS_GMSTAT);
    const int lane = F.lane, w = F.wave, l32 = lane & 31, hh = lane >> 5, blk = (lane >> 4) & 1, q4 = (lane & 15) >> 2, p4 = lane & 3;
    const int tr0 = F.tid >> 5, tc = F.tid & 31;
    for (int item = F.vcu; item < NB * 64; item += F.G) {
        const int b = item >> 6, n = item & 63;
        const size_t tok0 = (size_t)b * SEQ + (size_t)n * 128;
        const bf16_t* vsrc = PROJ + (tok0 + tr0) * GM_FFN + GM_HALF + tc * 8;
        bf16_t* usrc = PROJ + (tok0 + tr0) * GM_FFN + tc * 8;
        __syncthreads();
        if (F.tid < 128) { float s1 = 0.f, s2 = 0.f;
            for (int q = 0; q < 48; ++q) { const f32x2 v = *(const f32x2*)(stat + ((size_t)q * T + tok0 + F.tid) * 2); s1 += v.x; s2 += v.y; }
            const float m = s1 * (1.0f / GM_HALF), var = fmaxf(s2 * (1.0f / GM_HALF) - m * m, 0.f);
            mu[F.tid] = m; rs[F.tid] = 1.0f / sqrtf(var + EPS); }
        u32x4 vreg[8];
#pragma unroll
        for (int i = 0; i < 8; ++i) vreg[i] = *(const u32x4*)(vsrc + (size_t)(16 * i) * GM_FFN);
        __syncthreads();
        for (int un = 0; un < 12; ++un) {
            const int g = un / 3, th = un - 3 * g, cbase = g * 768 + th * 256;
            if (th == 0) {
                const int t = F.tid >> 2, qd = F.tid & 3; const float* wrow = p.gm_w_s + ((size_t)g * 128 + t) * 128 + 32 * qd;
                float cs = 0.f, rw = 0.f;
#pragma unroll
                for (int i = 0; i < 8; ++i) { const f32x4 wv = *(const f32x4*)(wrow + 4 * i); const int sidx = 32 * qd + 4 * i;
                    const float a0 = wv.x * rs[sidx], a1 = wv.y * rs[sidx + 1], a2 = wv.z * rs[sidx + 2], a3 = wv.w * rs[sidx + 3];
                    cs += (a0 * mu[sidx] + a1 * mu[sidx + 1]) + (a2 * mu[sidx + 2] + a3 * mu[sidx + 3]); rw += (wv.x + wv.y) + (wv.z + wv.w);
                    *(LAS u32x2*)(Wp + t * PW + sidx * 2) = pack4(a0, a1, a2, a3); }
                cs += __shfl_xor(cs, 1); cs += __shfl_xor(cs, 2); rw += __shfl_xor(rw, 1); rw += __shfl_xor(rw, 2);
                if (qd == 0) { corr[t] = cs; rsw[t] = rw; }
            }
#pragma unroll
            for (int i = 0; i < 8; ++i) *(LAS u32x4*)(Vt + (tr0 + 16 * i) * PVV + tc * 16) = vreg[i];
            __syncthreads();
            if (un < 11) { const int g2 = (un + 1) / 3, th2 = (un + 1) - 3 * g2; const bf16_t* vs2 = vsrc + g2 * 768 + th2 * 256;
#pragma unroll
                for (int i = 0; i < 8; ++i) vreg[i] = *(const u32x4*)(vs2 + (size_t)(16 * i) * GM_FFN); }
            const int tt = w & 3, cg = w >> 2;
            f32x16 acc[4];
#pragma unroll
            for (int e = 0; e < 4; ++e) acc[e] = zero16();
            const LAS unsigned char* aV = Vt + (8 * hh + q4) * PVV + 32 * blk + 8 * p4;
#pragma unroll
            for (int ks = 0; ks < 8; ++ks) {
                const bf16x8 wb = *(const LAS bf16x8*)(Wp + (32 * tt + l32) * PW + (16 * ks + 8 * hh) * 2);
#pragma unroll
                for (int e = 0; e < 4; ++e) { const int ct = 4 * cg + e;
                    const bf16x8 va = tr_read2(aV + (16 * ks) * PVV + 64 * ct, aV + (16 * ks + 4) * PVV + 64 * ct);
                    acc[e] = MFMA32(va, wb, acc[e]); }
            }
            __syncthreads();
            const int t = 32 * tt + l32; const float co = corr[t], rwt = rsw[t], bs = p.gm_b_s[g * 128 + t];
#pragma unroll
            for (int e = 0; e < 4; ++e)
#pragma unroll
                for (int g4 = 0; g4 < 4; ++g4) { const int cl = 32 * (4 * cg + e) + 8 * g4 + 4 * hh, c0 = cbase + cl;
                    const f32x4 lg = *(const f32x4*)(p.gm_ln_g + c0), lb = *(const f32x4*)(p.gm_ln_b + c0);
                    *(LAS u32x2*)(Vt + t * PVV + cl * 2) = pack4(lg.x * (acc[e][4 * g4] - co) + lb.x * rwt + bs, lg.y * (acc[e][4 * g4 + 1] - co) + lb.y * rwt + bs,
                                                                 lg.z * (acc[e][4 * g4 + 2] - co) + lb.z * rwt + bs, lg.w * (acc[e][4 * g4 + 3] - co) + lb.w * rwt + bs); }
            __syncthreads();
            {
                bf16_t* up = usrc + cbase; u32x4 uv[8];
#pragma unroll
                for (int i = 0; i < 8; ++i) uv[i] = *(const u32x4*)(up + (size_t)(16 * i) * GM_FFN);
#pragma unroll
                for (int i = 0; i < 8; ++i) { const u32x4 mv = *(const LAS u32x4*)(Vt + (tr0 + 16 * i) * PVV + tc * 16); u32x4 o;
                    o.x = cvt_pk_bf16(bf_lo(uv[i].x) * bf_lo(mv.x), bf_hi(uv[i].x) * bf_hi(mv.x)); o.y = cvt_pk_bf16(bf_lo(uv[i].y) * bf_lo(mv.y), bf_hi(uv[i].y) * bf_hi(mv.y));
                    o.z = cvt_pk_bf16(bf_lo(uv[i].z) * bf_lo(mv.z), bf_hi(uv[i].z) * bf_hi(mv.z)); o.w = cvt_pk_bf16(bf_lo(uv[i].w) * bf_lo(mv.w), bf_hi(uv[i].w) * bf_hi(mv.w));
                    *(u32x4*)(up + (size_t)(16 * i) * GM_FFN) = o; }
            }
            __syncthreads();
        }
    }
}

__device__ __forceinline__ void na_attn_phase(const Frame& F0, KP p) {
    const Frame F = relaunder(F0);
    constexpr int KS = 80, RING = 12, ROWB = 64 * KS;
    LAS unsigned char* Kl = F.lds; LAS unsigned char* Vl = F.lds + RING * ROWB; LAS float* rpbl = (LAS float*)(F.lds + 2 * RING * ROWB);
    bf16_t* PROJ = (bf16_t*)(p.ws + WS_PROJ);
    const int lane = F.lane, w = F.wave, n16 = lane & 15, g = lane >> 4, q4 = (lane & 15) >> 2, p4 = lane & 3;
    const int qrow = w >> 2, qb = w & 3;
    const int kc0 = qb == 0 ? 0 : qb == 1 ? 8 : qb == 2 ? 24 : 32;
    const int c = 16 * qb + n16, cstart = min(max(c - 8, 0), 48);
    for (int item = F.vcu; item < NB * 32 * 2; item += F.G) {
        const int half = item & 1, h = (item >> 1) & 31, b = item >> 6;
        const bf16_t* kvbase = PROJ + (size_t)b * SEQ * 3072 + h * 32;
        __syncthreads();
        for (int i = F.tid; i < 15 * 31; i += NTHREADS) rpbl[i] = p.na_rpb[(size_t)h * 465 + i];
        int loaded_hi;
        {
            const int rp = 32 * half, lo = min(max(2 * rp - 4, 0), 120), hi = min(max(2 * rp + 1 - 4, 0), 120) + 7, nrow = hi - lo + 1;
            for (int i = F.tid; i < nrow * 256; i += NTHREADS) { const int key = i >> 2, ch = i & 3, rr = lo + (key >> 6), kcol = key & 63;
                const bf16_t* src = kvbase + ((size_t)rr * 64 + kcol) * 3072 + ch * 8; const int off = ((rr % RING) * 64 + kcol) * KS + ch * 16;
                *(LAS u32x4*)(Kl + off) = *(const u32x4*)(src + 1024); *(LAS u32x4*)(Vl + off) = *(const u32x4*)(src + 2048); }
            loaded_hi = hi;
        }
        bf16x8 qf; { const int r = 2 * (32 * half) + qrow; qf = *(const bf16x8*)(PROJ + ((size_t)b * SEQ + r * 64 + c) * 3072 + h * 32 + 8 * g); }
        __syncthreads();
        f32x4 bt[16]; int tab_dr = -1000;
        for (int u = 0; u < 32; ++u) {
            const int rp = 32 * half + u, r = 2 * rp + qrow, r0 = min(max(r - 4, 0), 120);
            const size_t tokq = (size_t)b * SEQ + r * 64 + c;
            const bool has_next = u < 31;
            const int nhi = has_next ? min(max(2 * (rp + 1) + 1 - 4, 0), 120) + 7 : loaded_hi, nnew = nhi - loaded_hi;
            u32x4 kpre, vpre; int poff = -1;
            if (F.tid < nnew * 256) { const int key = F.tid >> 2, ch = F.tid & 3, rr = loaded_hi + 1 + (key >> 6), kcol = key & 63;
                const bf16_t* src = kvbase + ((size_t)rr * 64 + kcol) * 3072 + ch * 8; poff = ((rr % RING) * 64 + kcol) * KS + ch * 16;
                kpre = *(const u32x4*)(src + 1024); vpre = *(const u32x4*)(src + 2048); }
            bf16x8 qn = qf;
            if (has_next) qn = *(const bf16x8*)(PROJ + (tokq + 128) * 3072 + h * 32 + 8 * g);
            const int s0 = r0 % RING;
            f32x4 sacc[16];
#pragma unroll
            for (int tau = 0; tau < 16; ++tau) { const int kr = tau >> 1, hf = tau & 1; int slot = s0 + kr; slot = slot >= RING ? slot - RING : slot;
                const bf16x8 kf = *(const LAS bf16x8*)(Kl + (slot * 64 + kc0 + 16 * hf + n16) * KS + 16 * g);
                const f32x4 z4 = {0.f, 0.f, 0.f, 0.f}; sacc[tau] = MFMA16(kf, qf, z4); }
            if (r0 - r != tab_dr) { tab_dr = r0 - r;
#pragma unroll
                for (int tau = 0; tau < 16; ++tau) { const int kr = tau >> 1, hf = tau & 1; const int ro = tab_dr + kr + 7;
#pragma unroll
                    for (int i = 0; i < 4; ++i) { const int kcol = kc0 + 16 * hf + 4 * g + i; const bool ok = (kcol >= cstart) && (kcol < cstart + 16);
                        const int co = min(max(kcol - c + 15, 0), 30);
                        bt[tau][i] = ok ? rpbl[ro * 31 + co] * LOG2E : -3.0e38f; } } }
            float mx = -3.0e38f;
#pragma unroll
            for (int tau = 0; tau < 16; ++tau) { sacc[tau] = sacc[tau] + bt[tau]; mx = fmaxf(fmaxf(mx, fmaxf(sacc[tau][0], sacc[tau][1])), fmaxf(sacc[tau][2], sacc[tau][3])); }
            mx = fmaxf(mx, __shfl_xor(mx, 16)); mx = fmaxf(mx, __shfl_xor(mx, 32));
            float sum = 0.f;
#pragma unroll
            for (int tau = 0; tau < 16; ++tau)
#pragma unroll
                for (int i = 0; i < 4; ++i) { const float e = fast_exp2(sacc[tau][i] - mx); sacc[tau][i] = e; sum += e; }
            sum += __shfl_xor(sum, 16); sum += __shfl_xor(sum, 32);
            const float inv = 1.0f / sum;
            f32x4 oacc[2]; oacc[0] = (f32x4){0.f, 0.f, 0.f, 0.f}; oacc[1] = (f32x4){0.f, 0.f, 0.f, 0.f};
#pragma unroll
            for (int kr = 0; kr < 8; ++kr) {
                u32x4 pw; pw.x = cvt_pk_bf16(sacc[2 * kr][0], sacc[2 * kr][1]); pw.y = cvt_pk_bf16(sacc[2 * kr][2], sacc[2 * kr][3]); pw.z = cvt_pk_bf16(sacc[2 * kr + 1][0], sacc[2 * kr + 1][1]); pw.w = cvt_pk_bf16(sacc[2 * kr + 1][2], sacc[2 * kr + 1][3]);
                const bf16x8 pf = __builtin_bit_cast(bf16x8, pw);
                int slot = s0 + kr; slot = slot >= RING ? slot - RING : slot;
                const LAS unsigned char* a0 = Vl + (slot * 64 + kc0 + 4 * g + q4) * KS + 8 * p4; const LAS unsigned char* a1 = a0 + 16 * KS;
#pragma unroll
                for (int md = 0; md < 2; ++md) { const bf16x8 vf = tr_read2(a0 + 32 * md, a1 + 32 * md);
                    oacc[md] = MFMA16(vf, pf, oacc[md]); }
            }
            bf16_t* op = PROJ + tokq * 3072 + h * 32 + 4 * g;
            *(u32x2*)op = pack4(oacc[0][0] * inv, oacc[0][1] * inv, oacc[0][2] * inv, oacc[0][3] * inv);
            *(u32x2*)(op + 16) = pack4(oacc[1][0] * inv, oacc[1][1] * inv, oacc[1][2] * inv, oacc[1][3] * inv);
            if (poff >= 0) { *(LAS u32x4*)(Kl + poff) = kpre; *(LAS u32x4*)(Vl + poff) = vpre; }
            loaded_hi = nhi; qf = qn;
            __syncthreads();
        }
    }
}

#ifndef PHASE_MASK
#define PHASE_MASK 0xFFFFFFFFu
#endif
#define PH(k) ((PHASE_MASK >> (k)) & 1u)
#ifndef DBG_BARWAIT_CLS
#define DBG_BARWAIT_CLS -1
#endif
#define BAR(cls) do { TCK(cls); xcd_barrier_steal(bar); if ((cls) == DBG_BARWAIT_CLS || DBG_BARWAIT_CLS == -1) { TCK(13); } else { TCK(31); } } while (0)

__device__ __forceinline__ void moe_layer(const Frame& F, KP p, const XcdBarrier& bar, int layer, float* x) {
    if (PH(0)) moe_route_phase(F, p, layer, x);
    TCK(8); conv_drain(F, p, layer == 0 ? CQ_E_MOE0 : layer == 1 ? CQ_E_MOE1 : layer == 2 ? CQ_E_MOE2 : CQ_E_MOE3);
    BAR(14);
    const unsigned* cnt = (const unsigned*)(p.ws + WS_CTL) + CW_MOECNT + layer * 32;
    LAS int* tab = (LAS int*)(F.lds + pg8::STAGE_BYTES);
    const int NT = moe_tile_table(F, cnt, tab);
    const float* tok_wa = (const float*)(p.ws + WS_TOK); const float* tok_wb = tok_wa + T;
    {
        MoeSched S; S.G = F.G; S.c = F.vcu; S.NP = 8; S.NT = NT; S.tile_cls = tab; S.Abase = (const char*)(p.ws + WS_H2); S.rowtok = (const int*)(p.ws + WS_ROWTOK); S.cnt = cnt; S.head = (unsigned*)(p.ws + WS_CTL) + CW_MOEHEAD + (layer * 2 + 0) * 512; S.slot = (volatile LAS int*)(F.lds + pg8::STAGE_BYTES + 1024);
        S.wmat = (size_t)1024 * 1024 * 2; S.bntile = (size_t)256 * 1024 * 2; S.Wbase = (const char*)(p.ws + WS_W_MOE_GU) + (size_t)layer * 16 * S.wmat;
        EpiMoeGU E{(bf16_t*)(p.ws + WS_HID), tok_wa, tok_wb};
        if (PH(2)) pg8::gemm_phase<EpiMoeGU, MoeSched, true, 0, true>(F.lds, 1024, 1024, 1024, S, E);
    }
    BAR(10);
    {
        MoeSched S; S.G = F.G; S.c = F.vcu; S.NP = 4; S.NT = NT; S.tile_cls = tab; S.Abase = (const char*)(p.ws + WS_HID); S.rowtok = (const int*)(p.ws + WS_ROWTOK); S.cnt = cnt; S.head = (unsigned*)(p.ws + WS_CTL) + CW_MOEHEAD + (layer * 2 + 1) * 512; S.slot = (volatile LAS int*)(F.lds + pg8::STAGE_BYTES + 1024 + 16);
        S.wmat = (size_t)1024 * 512 * 2; S.bntile = (size_t)256 * 512 * 2; S.Wbase = (const char*)(p.ws + WS_W_MOE_DN) + (size_t)layer * 16 * S.wmat;
        EpiMoeDown E{x, (const float*)(p.ws + WS_MOD) + (size_t)layer * NB * 6144 + MOD_G2};
        if (PH(3)) pg8::gemm_phase<EpiMoeDown, MoeSched, true, 8, true>(F.lds, 1024, 1024, 512, S, E);
    }
    BAR(11);
}
template <class Epi>
__device__ __forceinline__ void dense_gemm(const Frame& F, int N, int K, const bf16_t* A, int lda, const bf16_t* Bt, int ldb, const Epi& E) {
    pg8::DenseOrder S; S.init(T, N, F.G, (int)blockIdx.x, A, (size_t)lda, Bt, (size_t)ldb);
    pg8::gemm_phase<Epi, pg8::DenseOrder, true, 0>(F.lds, K, lda, ldb, S, E);
}
__device__ __forceinline__ void retention_layer(const Frame& F, KP p, const XcdBarrier& bar, int layer, int j, const float* xin, float* xout) {
    const float* modl = (const float*)(p.ws + WS_MOD) + (size_t)layer * NB * 6144;
    bf16_t* H = (bf16_t*)(p.ws + WS_H); bf16_t* PROJ = (bf16_t*)(p.ws + WS_PROJ);
    if (PH(4)) norm_phase(F, xin, p.norm_g + (size_t)(layer * 2) * D, modl, MOD_SH1, MOD_SC1, H);
    TCK(1); conv_drain(F, p, j == 1 ? CQ_E_RET1 : CQ_E_RET0);
    BAR(14);
    if (PH(5)) { EpiRetIn E{PROJ}; dense_gemm(F, RET_IN, D, H, D, (const bf16_t*)(p.ws + WS_W_RET_IN) + (size_t)j * RET_IN * D, D, E); }
    BAR(2);
    if (PH(6)) ret_chain_phase(F, p, j);
    BAR(3);
    if (PH(7)) ret_intra_phase(F, p, j);
    BAR(4);
    if (PH(8)) { EpiResid E{xin, xout, modl + MOD_G1}; dense_gemm(F, D, 2048, PROJ + 4096, RET_IN, (const bf16_t*)(p.ws + WS_W_RET_OUT) + (size_t)j * D * 2048, 2048, E); }
    BAR(7);
}

__global__ void __launch_bounds__(NTHREADS, 2) fwd_kernel(Params p_by_value) {
    (void)p_by_value;
#define p (*kparams())
    extern __shared__ __attribute__((aligned(16))) unsigned char lds_raw[];
    Frame F;
    F.lds = (LAS unsigned char*)lds_raw;
    F.tid = 0; F.lane = 0; F.wave = 0;
    F.G = gridDim.x; { const int bx = blockIdx.x; F.vcu = (F.G % 8 == 0) ? (bx % 8) * (F.G / 8) + bx / 8 : bx; }
    volatile LAS unsigned* MISC = (volatile LAS unsigned*)(F.lds + MISC_OFF);
    if (threadIdx.x < 64) MISC[threadIdx.x] = 0u;
    __syncthreads();
    XcdBarrier bar = xcd_barrier_post((unsigned*)(p.ws + WS_CTL) + CW_BAR, MISC + 8);
    xcd_census(bar);
#ifdef DBG_AMP_MASK
    if (threadIdx.x == 0) ((volatile LAS unsigned long long*)((LAS unsigned char*)0 + DBG_MISC_OFF + 128))[0] = __builtin_amdgcn_s_memrealtime();
#endif
    float* x = p.out;
    bf16_t* H = (bf16_t*)(p.ws + WS_H); bf16_t* PROJ = (bf16_t*)(p.ws + WS_PROJ);

    if (PH(9)) p0_prologue(F, p);
    BAR(0);

    retention_layer(F, p, bar, 0, 0, p.x, x);
    moe_layer(F, p, bar, 0, x);

    {
        const float* modl = (const float*)(p.ws + WS_MOD) + (size_t)1 * NB * 6144;
        if (PH(4)) norm_phase(F, x, p.norm_g + (size_t)2 * D, modl, MOD_SH1, MOD_SC1, H);
        TCK(1); conv_drain(F, p, CQ_E_GM);
        BAR(14);
        if (PH(10)) { EpiGmIn E{PROJ, (float*)(p.ws + WS_GMSTAT)}; dense_gemm(F, GM_FFN, D, H, D, (const bf16_t*)(p.ws + WS_W_GM_IN), D, E); }
        BAR(2);
        if (PH(11)) gm_spatial_phase(F, p);
        BAR(5);
        if (PH(12)) { EpiResid E{x, x, modl + MOD_G1}; dense_gemm(F, D, GM_HALF, PROJ, GM_FFN, (const bf16_t*)(p.ws + WS_W_GM_OUT), GM_HALF, E); }
        BAR(7);
    }
    moe_layer(F, p, bar, 1, x);

    {
        const float* modl = (const float*)(p.ws + WS_MOD) + (size_t)2 * NB * 6144;
        if (PH(4)) norm_phase(F, x, p.norm_g + (size_t)4 * D, modl, MOD_SH1, MOD_SC1, H);
        TCK(1); conv_drain(F, p, CQ_E_NA);
        BAR(14);
        if (PH(13)) { EpiNaIn E{PROJ}; dense_gemm(F, 3 * D, D, H, D, (const bf16_t*)(p.ws + WS_W_NA_QKV), D, E); }
        BAR(2);
        if (PH(14)) na_attn_phase(F, p);
        BAR(6);
        if (PH(15)) { EpiResid E{x, x, modl + MOD_G1}; dense_gemm(F, D, D, PROJ, 3 * D, (const bf16_t*)(p.ws + WS_W_NA_OUT), D, E); }
        BAR(7);
    }
    moe_layer(F, p, bar, 2, x);

    retention_layer(F, p, bar, 3, 1, x, x);
    moe_layer(F, p, bar, 3, x);

    if (PH(16)) final_phase(F, x, p.final_g);
#ifdef DBG_AMP_MASK
    {
        __syncthreads(); TCK(12); __syncthreads();
        const unsigned long long wait = ((volatile LAS unsigned long long*)((LAS unsigned char*)0 + DBG_MISC_OFF + 128))[1] * (unsigned long long)(DBG_AMP_FACTOR);
        const unsigned long long t0 = __builtin_amdgcn_s_memrealtime();
        while (__builtin_amdgcn_s_memrealtime() - t0 < wait) __builtin_amdgcn_s_sleep(32);
    }
#endif
    if (__hip_atomic_load((unsigned*)(p.ws + WS_CTL) + CW_BAR + XB_TMO, __ATOMIC_RELAXED, __HIP_MEMORY_SCOPE_AGENT) != 0u) {
        __syncthreads();
        const float qn = __builtin_nanf("");
        for (size_t i = (size_t)blockIdx.x * NTHREADS + threadIdx.x; i < (size_t)T * D; i += (size_t)F.G * NTHREADS) x[i] = qn;
    }
#undef p
}

extern "C" void kernel_launch(void* const* d_in, const int* in_sizes, int n_in, void* d_out, int out_size, void* d_ws, size_t ws_size, hipStream_t stream) {
    static int grid = 0;
    if (grid == 0) {
        if (n_in != 22 || out_size != T * D || ws_size < WS_END) { fprintf(stderr, "kernel_launch: unexpected sizes (n_in %d, out %d, ws %zu; need ws >= %zu)\n", n_in, out_size, ws_size, (size_t)WS_END); grid = -1; return; }
        int dev = 0, cus = 0, per_cu = 0;
        if (hipGetDevice(&dev) != hipSuccess || hipDeviceGetAttribute(&cus, hipDeviceAttributeMultiprocessorCount, dev) != hipSuccess) { grid = -1; return; }
        if (hipFuncSetAttribute((const void*)fwd_kernel, hipFuncAttributeMaxDynamicSharedMemorySize, LDS_BYTES) != hipSuccess) { fprintf(stderr, "kernel_launch: hipFuncSetAttribute failed\n"); grid = -1; return; }
        if (hipOccupancyMaxActiveBlocksPerMultiprocessor(&per_cu, (const void*)fwd_kernel, NTHREADS, LDS_BYTES) != hipSuccess || per_cu < 1) fprintf(stderr, "kernel_launch: occupancy query reports %d\n", per_cu);
        (void)hipGetLastError();
        grid = cus;
    }
    if (grid < 0) return;
    if (hipMemsetAsync((char*)d_ws + WS_CTL, 0, CTL_ZERO_BYTES, stream) != hipSuccess) return;
    Params p{};
    const float** pf = (const float**)&p;
    for (int i = 0; i < 22; ++i) pf[i] = (const float*)d_in[i];
    p.out = (float*)d_out; p.ws = (unsigned char*)d_ws;
    hipLaunchKernelGGL(fwd_kernel, dim3(grid), dim3(NTHREADS), LDS_BYTES, stream, p);
}
```

```cpp
#include <hip/hip_runtime.h>
#include <cstdio>
#include <cstdint>

#define LAS __attribute__((address_space(3)))
#define GAS __attribute__((address_space(1)))
typedef unsigned short bf16_t;
typedef short bf16x8 __attribute__((ext_vector_type(8)));
typedef short s16x4 __attribute__((ext_vector_type(4)));
typedef float f32x4 __attribute__((ext_vector_type(4)));
typedef float f32x2 __attribute__((ext_vector_type(2)));
typedef float f32x16 __attribute__((ext_vector_type(16)));
typedef unsigned u32x4 __attribute__((ext_vector_type(4)));
typedef unsigned u32x2 __attribute__((ext_vector_type(2)));

constexpr int NB = 4, SEQ = 8192, T = NB * SEQ, D = 1024, DEPTH = 4;
constexpr int RET_IN = 6144, GM_FFN = 6144, GM_HALF = 3072;
constexpr int NCLS = 24;
constexpr int MOE_ROWS = T + NCLS * 256;
constexpr float EPS = 1e-6f;
constexpr float LOG2E = 1.4426950408889634f;

typedef __bf16 bf16x2_t __attribute__((ext_vector_type(2)));
__device__ __forceinline__ unsigned cvt_pk_bf16(float lo, float hi) { const f32x2 v = {lo, hi}; const bf16x2_t b = __builtin_convertvector(v, bf16x2_t); return __builtin_bit_cast(unsigned, b); }
__device__ __forceinline__ float bf_lo(unsigned w) { return __uint_as_float(w << 16); }
__device__ __forceinline__ float bf_hi(unsigned w) { return __uint_as_float(w & 0xffff0000u); }
__device__ __forceinline__ float fast_exp2(float x) { return __builtin_amdgcn_exp2f(x); }
__device__ __forceinline__ float fast_rcp(float x) { return __builtin_amdgcn_rcpf(x); }
__device__ __forceinline__ float silu_f(float x) { return x * fast_rcp(1.0f + fast_exp2(-x * LOG2E)); }

#define DBG_MISC_OFF (163840 - 256)
#ifdef DBG_AMP_MASK
#ifndef DBG_AMP_FACTOR
#define DBG_AMP_FACTOR 1
#endif
#define TCK(cls) do { if (threadIdx.x == 0) { volatile LAS unsigned long long* tk = (volatile LAS unsigned long long*)((LAS unsigned char*)0 + DBG_MISC_OFF + 128); const unsigned long long t_ = __builtin_amdgcn_s_memrealtime(); \
    if ((DBG_AMP_MASK >> (cls)) & 1) tk[1] += t_ - tk[0]; tk[0] = t_; } } while (0)
#else
#define TCK(cls) do { } while (0)
#endif
namespace pg8 {
constexpr int BM = 256, BK = 64, HALF = 128, HTB = HALF * BK * 2, STAGE_BYTES = 8 * HTB, NXCD = 8, WGM = 8;
__host__ __device__ __forceinline__ int lds_byte(int r, int c) { const int st = (r >> 4) * 2 + (c >> 5), rr = r & 15, cc = c & 31, ob = rr * 64 + cc * 2; return st * 1024 + (ob ^ (((ob >> 9) & 1) << 5)); }
__host__ __device__ __forceinline__ void stage_rc(int b, int& R, int& C) { const int st = b / 1024, sb = b % 1024, swz = sb ^ (((sb >> 9) & 1) << 5); R = (st >> 1) * 16 + swz / 64; C = (st & 1) * 32 + (swz % 64) / 2; }
__host__ __device__ __forceinline__ int perm32(int rho) { const int n = rho >> 4, i = rho & 15; return 8 * (i >> 2) + 4 * n + (i & 3); }

struct Unit { int pm, pn; const char* A; const char* B; const char* B2; int aux; const int* rt; int nvalid; };

struct DenseOrder {
    int nM, nN, nwg, G, c; const char* Abase; const char* Bbase; size_t atile, btile;
    __device__ void init(int M, int N, int G_, int c_, const void* A, size_t lda, const void* Bt, size_t ldb) { nM = M / BM; nN = N / BM; nwg = nM * nN; G = G_; c = c_; Abase = (const char*)A; Bbase = (const char*)Bt; atile = (size_t)BM * lda * 2; btile = (size_t)BM * ldb * 2; }
    __device__ bool next(int i, Unit& u) const {
        const long L = (long)i * G + c; if (L >= nwg) return false;
        int wgid = (int)L; { const int q = nwg / NXCD, r = nwg % NXCD, xcd = wgid % NXCD, off = wgid / NXCD; wgid = (xcd < r ? xcd * (q + 1) : r * (q + 1) + (xcd - r) * q) + off; }
        const int nig = WGM * nN, gid = wgid / nig, fm = gid * WGM, gsz = (nM - fm) < WGM ? (nM - fm) : WGM;
        u.pm = fm + ((wgid % nig) % gsz); u.pn = (wgid % nig) / gsz; u.A = Abase + (size_t)u.pm * atile; u.B = Bbase + (size_t)u.pn * btile; u.B2 = u.B; u.aux = 0; u.rt = nullptr; u.nvalid = 256; return true;
    }
};

__device__ __forceinline__ f32x2 gelu_pk(f32x2 v) {
    const f32x2 av = __builtin_elementwise_abs(v), d = av * 0.2316418882f + 1.0f;
    f32x2 t; t.x = __builtin_amdgcn_rcpf(d.x); t.y = __builtin_amdgcn_rcpf(d.y);
    f32x2 q = t * 0.5307027145f + (-0.7265760135f); q = q * t + 0.7107068705f; q = q * t + (-0.142248368f); q = q * t + 0.127414796f; q = q * t;
    const f32x2 s = (v * v) * (-0.72134752044f);
    f32x2 e; e.x = __builtin_amdgcn_exp2f(s.x); e.y = __builtin_amdgcn_exp2f(s.y);
    const f32x2 m = v * (q * e), r = v - m;
    f32x2 o; o.x = v.x < 0.f ? m.x : r.x; o.y = v.y < 0.f ? m.y : r.y; return o;
}

constexpr int PADROW = 32768;
template <class Epi, class Sched, bool ALIGN_EPI, int KSW, bool GATHER = false>
__device__ __forceinline__ void gemm_phase(LAS unsigned char* lds, const int K, const int lda, const int ldb, const Sched& S, const Epi& E) {
    int tid_ = threadIdx.x; asm volatile("" : "+v"(tid_));
    const int tid = tid_, wid = __builtin_amdgcn_readfirstlane(tid >> 6), lane = tid & 63, wr = wid >> 2, wc = wid & 3, fr = lane & 15, fq = lane >> 4;
    const int nt = K / BK;
    unsigned voffA[2], voffB[2]; int rowA[2];
#pragma unroll
    for (int i = 0; i < 2; ++i) { int R, C; stage_rc(tid * 16 + i * 8192, R, C); const int Rb = Epi::PERM ? ((R & ~31) + perm32(R & 31)) : R;
        voffA[i] = GATHER ? (unsigned)C * 2u : (unsigned)(R * lda + C) * 2u; voffB[i] = (unsigned)(Rb * ldb + C) * 2u; rowA[i] = R; }
    unsigned vc0[2], vc1[2], vn0[2], vn1[2];
#define PG8_GOFF(u_, dst0, dst1) do { _Pragma("unroll") for (int _i = 0; _i < 2; ++_i) { \
        if constexpr (GATHER) { const int r0_ = rowA[_i], r1_ = rowA[_i] + HALF; \
            const int t0_ = (r0_ < (u_).nvalid) ? (u_).rt[r0_] : PADROW, t1_ = (r1_ < (u_).nvalid) ? (u_).rt[r1_] : PADROW; \
            dst0[_i] = (unsigned)t0_ * (unsigned)(lda * 2) + voffA[_i]; dst1[_i] = (unsigned)t1_ * (unsigned)(lda * 2) + voffA[_i]; } \
        else { dst0[_i] = voffA[_i]; dst1[_i] = voffA[_i] + (unsigned)hstepA; } } } while (0)
    const size_t kstep = (size_t)(BK * 2);
    const size_t hstepA = (size_t)HALF * lda * 2, hstepB = (size_t)HALF * ldb * 2;
    const unsigned ldsw = (unsigned)wid * 1024u;
    const int aoff = lds_byte(wr * 64 + fr, fq * 8), boff = lds_byte(wc * 32 + fr, fq * 8);
#define PG8_SA(b, h) (((b) * 2 + (h)) * HTB)
#define PG8_SB(b, h) ((4 + (b) * 2 + (h)) * HTB)
#define PG8_STAGE(bufoff, gbase, voff) do { _Pragma("unroll") for (int _i = 0; _i < 2; ++_i) \
        __builtin_amdgcn_global_load_lds((const unsigned*)((const char*)(gbase) + (voff)[_i]), (LAS unsigned*)(lds + (bufoff) + ldsw + _i * 8192), 16, 0, 0); } while (0)
#define PG8_LDA(dst, b, h) do { _Pragma("unroll") for (int m = 0; m < 4; ++m) _Pragma("unroll") for (int k = 0; k < 2; ++k) dst[m][k] = *(const LAS bf16x8*)(lds + PG8_SA(b, h) + aoff + m * 2048 + k * 1024); } while (0)
#define PG8_LDB(dst, b, h) do { _Pragma("unroll") for (int n = 0; n < 2; ++n) _Pragma("unroll") for (int k = 0; k < 2; ++k) dst[n][k] = *(const LAS bf16x8*)(lds + PG8_SB(b, h) + boff + n * 2048 + k * 1024); } while (0)
#define PG8_MMA(ai, bj, At, Bt) do { __builtin_amdgcn_s_setprio(1); _Pragma("unroll") for (int m = 0; m < 4; ++m) _Pragma("unroll") for (int n = 0; n < 2; ++n) _Pragma("unroll") for (int k = 0; k < 2; ++k) \
        acc[ai][bj][m][n] = __builtin_amdgcn_mfma_f32_16x16x32_bf16(Bt[n][k], At[m][k], acc[ai][bj][m][n], 0, 0, 0); __builtin_amdgcn_s_setprio(0); } while (0)
#define PG8_WAIT_V(n) asm volatile("s_waitcnt vmcnt(" #n ")" ::: "memory")
#define PG8_WAIT_L(n) asm volatile("s_waitcnt lgkmcnt(" #n ")" ::: "memory")
#define PG8_BAR __builtin_amdgcn_s_barrier()
#define PG8_SCHED __builtin_amdgcn_sched_barrier(0)
#define PG8_BPTR(u_, t_) ((KSW > 0 && (t_) >= KSW) ? (u_).B2 + (size_t)((t_) - KSW) * kstep : (u_).B + (size_t)(t_) * kstep)
    Unit cur, nxt; int ui = 0;
    if (!S.next(0, cur)) return;
    f32x4 acc[2][2][4][2];
    bf16x8 At[4][2], B0[2][2], B1[2][2];
    const char* cA = cur.A; const char* cB = cur.B;
    PG8_GOFF(cur, vc0, vc1);
    PG8_STAGE(PG8_SB(0, 0), cB, voffB); PG8_STAGE(PG8_SB(0, 1), cB + hstepB, voffB); PG8_STAGE(PG8_SA(0, 0), cA, vc0); PG8_STAGE(PG8_SA(0, 1), cA, vc1);
    if (wr == 1) PG8_BAR;
    PG8_WAIT_V(2); PG8_BAR;
    PG8_STAGE(PG8_SB(1, 0), cB + kstep, voffB); PG8_STAGE(PG8_SA(1, 0), cA + kstep, vc0); PG8_STAGE(PG8_SB(1, 1), cB + hstepB + kstep, voffB);
    PG8_WAIT_V(6); PG8_BAR;
    for (;;) {
        const bool has_next = S.next(ui + 1, nxt);
        const char* nA = has_next ? nxt.A : cA; const char* nB = has_next ? nxt.B : cB;
        if constexpr (GATHER) { if (has_next) { PG8_GOFF(nxt, vn0, vn1); } else {
#pragma unroll
            for (int _i = 0; _i < 2; ++_i) { vn0[_i] = vc0[_i]; vn1[_i] = vc1[_i]; } } }
        if constexpr (GATHER) { TCK(23); }
#pragma unroll
        for (int a = 0; a < 2; ++a)
#pragma unroll
            for (int b = 0; b < 2; ++b)
#pragma unroll
                for (int m = 0; m < 4; ++m)
#pragma unroll
                    for (int n = 0; n < 2; ++n) acc[a][b][m][n] = (f32x4){0.f, 0.f, 0.f, 0.f};

        for (int t = 0; t < nt; t += 2) {
            const bool last = (t == nt - 2);
            const char* a1 = cA + (size_t)(t + 1) * kstep;
            const char* a2 = last ? nA : cA + (size_t)(t + 2) * kstep; const char* b2 = last ? nB : PG8_BPTR(cur, t + 2);
            const char* a3 = a2 + kstep; const char* b3 = last ? nB + kstep : PG8_BPTR(cur, t + 3);
            unsigned va0[2], va1[2];
#pragma unroll
            for (int _i = 0; _i < 2; ++_i) { va0[_i] = (GATHER && last) ? vn0[_i] : vc0[_i]; va1[_i] = (GATHER && last) ? vn1[_i] : vc1[_i]; }
            PG8_LDB(B0, 0, 0); PG8_LDB(B1, 0, 1); PG8_SCHED; PG8_LDA(At, 0, 0); PG8_STAGE(PG8_SA(1, 1), a1, vc1);
            PG8_WAIT_V(8); PG8_WAIT_L(0); PG8_BAR; PG8_MMA(0, 0, At, B0); PG8_MMA(0, 1, At, B1); PG8_BAR; PG8_SCHED;
            PG8_LDA(At, 0, 1); PG8_STAGE(PG8_SB(0, 0), b2, voffB); PG8_STAGE(PG8_SB(0, 1), b2 + hstepB, voffB); PG8_STAGE(PG8_SA(0, 0), a2, va0);
            PG8_WAIT_V(8); PG8_WAIT_L(0); PG8_BAR; PG8_MMA(1, 0, At, B0); PG8_MMA(1, 1, At, B1); PG8_BAR; PG8_SCHED;
            PG8_LDB(B0, 1, 0); PG8_LDB(B1, 1, 1); PG8_SCHED; PG8_LDA(At, 1, 0); PG8_STAGE(PG8_SA(0, 1), a2, va1);
            PG8_WAIT_V(8); PG8_WAIT_L(0); PG8_BAR; PG8_MMA(0, 0, At, B0); PG8_MMA(0, 1, At, B1); PG8_BAR; PG8_SCHED;
            PG8_LDA(At, 1, 1); PG8_STAGE(PG8_SB(1, 0), b3, voffB); PG8_STAGE(PG8_SB(1, 1), b3 + hstepB, voffB); PG8_STAGE(PG8_SA(1, 0), a3, va0);
            PG8_WAIT_V(8); PG8_WAIT_L(0); PG8_BAR; PG8_MMA(1, 0, At, B0); PG8_MMA(1, 1, At, B1); PG8_BAR; PG8_SCHED;
        }
        if constexpr (ALIGN_EPI) { if (wr == 0) PG8_BAR; }
        if constexpr (GATHER) { TCK(21); }
        E(acc, cur, wr, wc, fr, fq);
        if constexpr (GATHER) { TCK(22); }
        if (!has_next) break;
        cur = nxt; cA = nA; cB = nB; ++ui;
        if constexpr (GATHER) {
#pragma unroll
            for (int _i = 0; _i < 2; ++_i) { vc0[_i] = vn0[_i]; vc1[_i] = vn1[_i]; } }
        if constexpr (ALIGN_EPI) { if (wr == 1) PG8_BAR; }
    }
    PG8_WAIT_V(0);
    if constexpr (!ALIGN_EPI) { if (wr == 0) PG8_BAR; }
    PG8_BAR;
#undef PG8_SA
#undef PG8_SB
#undef PG8_STAGE
#undef PG8_LDA
#undef PG8_LDB
#undef PG8_MMA
#undef PG8_WAIT_V
#undef PG8_WAIT_L
#undef PG8_BAR
#undef PG8_SCHED
#undef PG8_BPTR
#undef PG8_GOFF
}
}

#define XB_TMO      128
#define XB_XCNT(j)  (256  + 64 * (j))
#define XB_XSUB(j)  (1280 + 64 * (j))
#define XB_XGEN(j)  (2304 + 64 * (j))
#define XB_TOP      3328
#define XB_TOPGEN   3392
#define XCD_BAR_WORDS 3456
#define XB_SPIN_CAP (1u << 22)

__device__ __forceinline__ unsigned xb_ld(unsigned* p)              { return __hip_atomic_load(p, __ATOMIC_RELAXED, __HIP_MEMORY_SCOPE_AGENT); }
__device__ __forceinline__ unsigned xb_add(unsigned* p, unsigned v) { return __hip_atomic_fetch_add(p, v, __ATOMIC_RELAXED, __HIP_MEMORY_SCOPE_AGENT); }
__device__ __forceinline__ unsigned xb_xcc_id() { return (unsigned)__builtin_amdgcn_s_getreg((3 << 11) | 20) & 0xFu; }
#define XB_SPIN(cond, bar) do { unsigned _sp = 0; while (cond) { __builtin_amdgcn_s_sleep(1); \
    if ((++_sp & 255u) == 0u) { if (xb_ld(&(bar)[XB_TMO])) break; if (_sp > XB_SPIN_CAP) { atomicAdd(&(bar)[XB_TMO], 1u); break; } } } } while (0)

struct XcdBarrier { unsigned* bar; unsigned x; volatile LAS unsigned* st; };

__device__ __forceinline__ XcdBarrier xcd_barrier_post(unsigned* bar, volatile LAS unsigned* st) {
    XcdBarrier b; b.bar = bar; b.x = xb_xcc_id(); b.st = st;
    if (threadIdx.x == 0) (void)xb_add(&bar[XB_XCNT(b.x)], 1u);
    return b;
}
__device__ __forceinline__ void xcd_barrier_complete(unsigned* bar, unsigned x, unsigned& nloc, unsigned& nx) {
    const unsigned G = gridDim.x * gridDim.y * gridDim.z;
    unsigned sum, cnt, mine, sp = 0u;
    for (;;) {
        sum = 0u; cnt = 0u; mine = 0u;
#pragma unroll
        for (unsigned j = 0; j < 16; ++j) { const unsigned c = xb_ld(&bar[XB_XCNT(j)]); sum += c; cnt += (c > 0u) ? 1u : 0u; }
        if (sum == G) { mine = xb_ld(&bar[XB_XCNT(x)]); break; }
        __builtin_amdgcn_s_sleep(1);
        if ((++sp & 255u) == 0u) { if (xb_ld(&bar[XB_TMO])) break; if (sp > XB_SPIN_CAP) { atomicAdd(&bar[XB_TMO], 1u); break; } }
    }
    nloc = mine > 0u ? mine : 1u; nx = cnt > 0u ? cnt : 1u;
}
__device__ __forceinline__ void xcd_census(const XcdBarrier& b) {
    if (threadIdx.x == 0) { unsigned nloc, nx; xcd_barrier_complete(b.bar, b.x, nloc, nx); b.st[0] = nloc; b.st[1] = nx; }
    __syncthreads();
}
__device__ __forceinline__ void xcd_barrier(const XcdBarrier& b) {
    asm volatile("s_waitcnt vmcnt(0)" ::: "memory");
    __syncthreads();
    if (threadIdx.x == 0) {
        unsigned* bar = b.bar;
        __builtin_amdgcn_s_waitcnt(0);
        const unsigned nloc = b.st[0], nx = b.st[1];
        const unsigned old = xb_add(&bar[XB_XSUB(b.x)], 1u);
        const unsigned gen = old / nloc;
        if (old + 1u == (gen + 1u) * nloc) {
            __builtin_amdgcn_fence(__ATOMIC_RELEASE, "agent");
            asm volatile("s_waitcnt vmcnt(0)" ::: "memory");
            const unsigned og = xb_add(&bar[XB_TOP], 1u);
            const unsigned tg = og / nx;
            if (og + 1u == (tg + 1u) * nx) xb_add(&bar[XB_TOPGEN], 1u);
            else XB_SPIN(xb_ld(&bar[XB_TOPGEN]) == tg, bar);
            __builtin_amdgcn_fence(__ATOMIC_ACQUIRE, "agent");
            xb_add(&bar[XB_XGEN(b.x)], 1u);
            asm volatile("s_waitcnt vmcnt(0)" ::: "memory");
        } else {
            XB_SPIN(xb_ld(&bar[XB_XGEN(b.x)]) == gen, bar);
            __builtin_amdgcn_fence(__ATOMIC_ACQUIRE, "agent");
            asm volatile("s_waitcnt vmcnt(0)" ::: "memory");
        }
    }
    __syncthreads();
}
__device__ const float INVF_REV[128] = {1.591549367e-01f, 1.481051445e-01f, 1.378225088e-01f, 1.282537729e-01f, 1.193493679e-01f, 1.110631898e-01f, 1.033522934e-01f, 9.617675841e-02f, 8.949939907e-02f, 8.328563720e-02f, 7.750328630e-02f, 7.212239504e-02f, 6.711508334e-02f, 6.245541945e-02f, 5.811926723e-02f, 5.408416688e-02f, 5.032921210e-02f, 4.683495685e-02f, 4.358330369e-02f, 4.055740312e-02f, 3.774158657e-02f, 3.512126207e-02f, 3.268286586e-02f, 3.041376173e-02f, 2.830219641e-02f, 2.633723244e-02f, 2.450869232e-02f, 2.280710265e-02f, 2.122365311e-02f, 1.975013874e-02f, 1.837892644e-02f, 1.710291393e-02f, 1.591549441e-02f, 1.481051371e-02f, 1.378225069e-02f, 1.282537635e-02f, 1.193493698e-02f, 1.110631879e-02f, 1.033522934e-02f, 9.617676027e-03f, 8.949940093e-03f, 8.328564465e-03f, 7.750329096e-03f, 7.212239318e-03f, 6.711508147e-03f, 6.245541852e-03f, 5.811926909e-03f, 5.408416502e-03f, 5.032921210e-03f, 4.683495965e-03f, 4.358330276e-03f, 4.055740312e-03f, 3.774158424e-03f, 3.512126394e-03f, 3.268286586e-03f, 3.041376127e-03f, 2.830219688e-03f, 2.633723198e-03f, 2.450869186e-03f, 2.280710265e-03f, 2.122365171e-03f, 1.975013874e-03f, 1.837892574e-03f, 1.710291486e-03f, 1.591549488e-03f, 1.481051440e-03f, 1.378225046e-03f, 1.282537705e-03f, 1.193493721e-03f, 1.110631856e-03f, 1.033523004e-03f, 9.617675678e-04f, 8.949940093e-04f, 8.328563999e-04f, 7.750329096e-04f, 7.212239434e-04f, 6.711508031e-04f, 6.245541736e-04f, 5.811926676e-04f, 5.408416619e-04f, 5.032921326e-04f, 4.683495790e-04f, 4.358330334e-04f, 4.055740137e-04f, 3.774158540e-04f, 3.512126277e-04f, 3.268286528e-04f, 3.041376185e-04f, 2.830219455e-04f, 2.633723198e-04f, 2.450869069e-04f, 2.280710323e-04f, 2.122365258e-04f, 1.975013729e-04f, 1.837892632e-04f, 1.710291544e-04f, 1.591549371e-04f, 1.481051440e-04f, 1.378224988e-04f, 1.282537705e-04f, 1.193493736e-04f, 1.110631856e-04f, 1.033522931e-04f, 9.617675823e-05f, 8.949940093e-05f, 8.328563854e-05f, 7.750328950e-05f, 7.212239143e-05f, 6.711508468e-05f, 6.245542318e-05f, 5.811926894e-05f, 5.408416473e-05f, 5.032921035e-05f, 4.683495717e-05f, 4.358330261e-05f, 4.055740283e-05f, 3.774158540e-05f, 3.512126204e-05f, 3.268286673e-05f, 3.041376112e-05f, 2.830219637e-05f, 2.633723125e-05f, 2.450869215e-05f, 2.280710396e-05f, 2.122365186e-05f, 1.975013765e-05f, 1.837892523e-05f, 1.710291508e-05f};

constexpr size_t MiB = (size_t)1 << 20;
constexpr size_t WS_CTL = 0, CTL_ZERO_BYTES = 128 * 1024;
constexpr int CW_BAR = 4096, CW_MOECNT = 16384;
constexpr int CW_MOEDONE = 28672;
constexpr int CW_CONVQ = 24576;
constexpr size_t WS_MOD = 1 * MiB;
constexpr size_t WS_TOK = 2 * MiB;
constexpr size_t WS_ROW = 3 * MiB;
constexpr size_t WS_W_RET_IN = 4 * MiB, WS_W_RET_OUT = 28 * MiB, WS_W_GM_IN = 36 * MiB, WS_W_GM_OUT = 48 * MiB, WS_W_NA_QKV = 54 * MiB, WS_W_NA_OUT = 60 * MiB;
constexpr size_t WS_W_MOE_GU = 64 * MiB, WS_W_MOE_DN = 192 * MiB;
constexpr size_t WS_PROJ = 256 * MiB;
constexpr size_t WS_REGB = 640 * MiB;
constexpr size_t WS_CROSSF = WS_REGB, WS_CROSSB = WS_REGB + 128 * MiB;
constexpr size_t WS_H = WS_REGB;
constexpr size_t WS_GMSTAT = WS_REGB + 64 * MiB;
constexpr size_t WS_H2 = WS_REGB;
constexpr size_t WS_HID = WS_REGB + 80 * MiB;
constexpr size_t WS_ROWTOK = WS_REGB + 160 * MiB;
constexpr size_t WS_END = 896 * MiB;
constexpr int MOD_SH1 = 0, MOD_SC1 = 1024, MOD_G1 = 2048, MOD_SH2 = 3072, MOD_SC2 = 4096, MOD_G2 = 5120;

constexpr int NWAVES = 8, NTHREADS = 512;
constexpr int LDS_BYTES = 163840;
constexpr int MISC_OFF = LDS_BYTES - 256;

struct Params {
    const float *x, *c, *norm_g, *final_g, *w_ada, *b_ada, *ret_w_in, *ret_decay, *ret_w_out, *gm_w_in, *gm_ln_g, *gm_ln_b, *gm_w_s, *gm_b_s, *gm_w_out,
                *na_w_qkv, *na_rpb, *na_w_out, *router_w, *router_b, *moe_gu, *moe_dn;
    float* out; unsigned char* ws;
};

typedef const __attribute__((address_space(4))) Params KParams;
typedef KParams& KP;
__device__ __forceinline__ KParams* kparams() { KParams* q = (KParams*)__builtin_amdgcn_kernarg_segment_ptr(); asm volatile("" : "+s"(q)); return q; }

struct Frame {
    LAS unsigned char* lds; int tid, lane, wave, vcu, G;
};
__device__ __forceinline__ Frame relaunder(const Frame& F0) { Frame F = F0; int t = threadIdx.x; asm volatile("" : "+v"(t)); F.tid = t; F.lane = t & 63; F.wave = __builtin_amdgcn_readfirstlane(t >> 6); return F; }

template <int CTRL> __device__ __forceinline__ float dpp_mov(float v) { return __builtin_bit_cast(float, __builtin_amdgcn_update_dpp(0, __builtin_bit_cast(int, v), CTRL, 0xf, 0xf, true)); }
__device__ __forceinline__ float wave_sum(float v) {
    v += dpp_mov<0xB1>(v);
    v += dpp_mov<0x4E>(v);
    v += dpp_mov<0x141>(v);
    v += dpp_mov<0x140>(v);
    const int iv = __builtin_bit_cast(int, v);
    const float r0 = __builtin_bit_cast(float, __builtin_amdgcn_readlane(iv, 0)), r1 = __builtin_bit_cast(float, __builtin_amdgcn_readlane(iv, 16));
    const float r2 = __builtin_bit_cast(float, __builtin_amdgcn_readlane(iv, 32)), r3 = __builtin_bit_cast(float, __builtin_amdgcn_readlane(iv, 48));
    return (r0 + r1) + (r2 + r3);
}
#define LDS_WAIT() asm volatile("s_waitcnt lgkmcnt(0)" ::: "memory")

template <int ROWS, int COLS>
__device__ __forceinline__ void load_tile(LAS unsigned char* dst, int pitch, const bf16_t* src, size_t ld, int tid_) {
    constexpr int CPR = COLS / 8, TOTAL = ROWS * CPR;
    int tid = tid_; asm volatile("" : "+v"(tid));
#pragma unroll
    for (int i0 = 0; i0 < TOTAL; i0 += NTHREADS) { const int i = i0 + tid; if (TOTAL % NTHREADS == 0 || i < TOTAL) { const int r = i / CPR, c = i % CPR;
        const u32x4 v = *(const u32x4*)(src + (size_t)r * ld + c * 8); *(LAS u32x4*)(dst + r * pitch + c * 16) = v; } }
}
__device__ __forceinline__ bf16x8 tr_read2(const LAS unsigned char* a0, const LAS unsigned char* a1) {
    const s16x4 lo = __builtin_amdgcn_ds_read_tr16_b64_v4i16((LAS s16x4*)a0), hi = __builtin_amdgcn_ds_read_tr16_b64_v4i16((LAS s16x4*)a1);
    return __builtin_shufflevector(lo, hi, 0, 1, 2, 3, 4, 5, 6, 7);
}
#define MFMA32(a, b, c) __builtin_amdgcn_mfma_f32_32x32x16_bf16((a), (b), (c), 0, 0, 0)
#define MFMA16(a, b, c) __builtin_amdgcn_mfma_f32_16x16x32_bf16((a), (b), (c), 0, 0, 0)
__device__ __forceinline__ f32x16 zero16() { f32x16 z; for (int i = 0; i < 16; ++i) z[i] = 0.f; return z; }

__device__ __forceinline__ void p0_transpose_item(const float* W, int K, int N, bf16_t* WT, int k0, int n0, int drow0, LAS float* scr, int lane) {
#pragma unroll 16
    for (int i = 0; i < 32; ++i) { const int kk = 2 * i + (lane >> 5); scr[kk * 33 + (lane & 31)] = W[(size_t)(k0 + kk) * N + n0 + (lane & 31)]; }
    LDS_WAIT(); asm volatile("" ::: "memory");
    const int c = lane & 7;
#pragma unroll
    for (int j = 0; j < 4; ++j) { const int n = (lane >> 3) + 8 * j; const LAS float* s = scr + (8 * c) * 33 + n;
        u32x4 o; o.x = cvt_pk_bf16(s[0 * 33], s[1 * 33]); o.y = cvt_pk_bf16(s[2 * 33], s[3 * 33]); o.z = cvt_pk_bf16(s[4 * 33], s[5 * 33]); o.w = cvt_pk_bf16(s[6 * 33], s[7 * 33]);
        *(u32x4*)(WT + (size_t)(drow0 + n) * K + k0 + 8 * c) = o; }
    LDS_WAIT(); asm volatile("" ::: "memory");
}
constexpr int CQ_RET_IN = 16 * 192, CQ_RET_OUT = 32 * 32, CQ_MOE_GU = 16 * 16 * 32, CQ_MOE_DN = 16 * 8 * 32, CQ_MOE = CQ_MOE_GU + CQ_MOE_DN;
constexpr int CQ_GM_IN = 16 * 192, CQ_GM_OUT = 48 * 32, CQ_NA_QKV = 16 * 96, CQ_NA_OUT = 16 * 32;
constexpr int CQ_E_RET0 = CQ_RET_IN + CQ_RET_OUT, CQ_E_MOE0 = CQ_E_RET0 + CQ_MOE, CQ_E_GM = CQ_E_MOE0 + CQ_GM_IN + CQ_GM_OUT, CQ_E_MOE1 = CQ_E_GM + CQ_MOE;
constexpr int CQ_E_NA = CQ_E_MOE1 + CQ_NA_QKV + CQ_NA_OUT, CQ_E_MOE2 = CQ_E_NA + CQ_MOE, CQ_E_RET1 = CQ_E_MOE2 + CQ_RET_IN + CQ_RET_OUT, CQ_E_MOE3 = CQ_E_RET1 + CQ_MOE, CQ_TOTAL = CQ_E_MOE3;
#ifndef CQ_STEAL
#define CQ_STEAL 1
#endif
#define CQ_JOB(SRC, DST, K_, N_, GU_) { constexpr int nnb_ = (N_) / 32, per_ = ((K_) / 64) * nnb_; const int mat_ = r / per_, rr_ = r % per_; kb = rr_ / nnb_; nb = rr_ % nnb_; K = (K_); N = (N_); gu = (GU_); \
    src = (SRC) + (size_t)mat_ * (K_) * (N_); dst = (bf16_t*)(p.ws + (DST)) + (size_t)mat_ * (K_) * (N_); }
__device__ __forceinline__ void conv_item(KP p, int it  , LAS float* scr, int lane) {
    const float* src; bf16_t* dst; int K, N, kb, nb, r = it; bool gu;
    int layer = -1;
    if (r < CQ_E_RET0) { if (r < CQ_RET_IN) CQ_JOB(p.ret_w_in, WS_W_RET_IN, D, RET_IN, false) else { r -= CQ_RET_IN; CQ_JOB(p.ret_w_out, WS_W_RET_OUT, 2048, D, false) } }
    else if (r < CQ_E_MOE0) { r -= CQ_E_RET0; layer = 0; }
    else if (r < CQ_E_GM) { r -= CQ_E_MOE0; if (r < CQ_GM_IN) CQ_JOB(p.gm_w_in, WS_W_GM_IN, D, GM_FFN, false) else { r -= CQ_GM_IN; CQ_JOB(p.gm_w_out, WS_W_GM_OUT, GM_HALF, D, false) } }
    else if (r < CQ_E_MOE1) { r -= CQ_E_GM; layer = 1; }
    else if (r < CQ_E_NA) { r -= CQ_E_MOE1; if (r < CQ_NA_QKV) CQ_JOB(p.na_w_qkv, WS_W_NA_QKV, D, 3 * D, false) else { r -= CQ_NA_QKV; CQ_JOB(p.na_w_out, WS_W_NA_OUT, D, D, false) } }
    else if (r < CQ_E_MOE2) { r -= CQ_E_NA; layer = 2; }
    else if (r < CQ_E_RET1) { r -= CQ_E_MOE2; if (r < CQ_RET_IN) CQ_JOB(p.ret_w_in + (size_t)D * RET_IN, WS_W_RET_IN + (size_t)D * RET_IN * 2, D, RET_IN, false) else { r -= CQ_RET_IN; CQ_JOB(p.ret_w_out + (size_t)2048 * D, WS_W_RET_OUT + (size_t)2048 * D * 2, 2048, D, false) } }
    else { r -= CQ_E_RET1; layer = 3; }
    if (layer >= 0) {
        if (r < CQ_MOE_GU) CQ_JOB(p.moe_gu + (size_t)layer * 16 * 1024 * 1024, WS_W_MOE_GU + (size_t)layer * 16 * 1024 * 1024 * 2, D, 1024, true)
        else { r -= CQ_MOE_GU; CQ_JOB(p.moe_dn + (size_t)layer * 16 * 512 * 1024, WS_W_MOE_DN + (size_t)layer * 16 * 512 * 1024 * 2, 512, D, false) }
    }
    const int n0 = nb * 32;
    int drow0 = n0;
    if (gu) drow0 = (n0 < 512) ? ((n0 >> 7) * 256 + (n0 & 127)) : (((n0 - 512) >> 7) * 256 + 128 + ((n0 - 512) & 127));
    p0_transpose_item(src, K, N, dst, kb * 64, n0, drow0, scr, lane);
}
constexpr int CQ_BATCH = 8;
struct ConvWave { unsigned* ctr; int q, nq; volatile LAS unsigned* st; unsigned hw, lo, hi; };
__device__ __forceinline__ ConvWave conv_wave(unsigned* ctl, LAS unsigned char* lds, int wave) {
    ConvWave w; const int G = gridDim.x; w.nq = (G % 8 == 0) ? 8 : 1; w.q = (G % 8 == 0) ? (int)(blockIdx.x & 7) : 0; w.ctr = ctl + CW_CONVQ + 64 * w.q;
    w.st = (volatile LAS unsigned*)(lds + MISC_OFF);
    w.hw = __builtin_amdgcn_readfirstlane(w.st[16 + wave]); w.lo = __builtin_amdgcn_readfirstlane(w.st[40 + 2 * wave]); w.hi = __builtin_amdgcn_readfirstlane(w.st[41 + 2 * wave]);
    return w;
}
__device__ __forceinline__ void conv_wave_save(const ConvWave& w, int wave) { w.st[16 + wave] = w.hw; w.st[40 + 2 * wave] = w.lo; w.st[41 + 2 * wave] = w.hi; }
__device__ __forceinline__ void conv_claim(ConvWave& w, int lane) {
    int c = 0; if (lane == 0) c = (int)__hip_atomic_fetch_add(w.ctr, 1u, __ATOMIC_RELAXED, __HIP_MEMORY_SCOPE_AGENT);
    c = __builtin_amdgcn_readfirstlane(c);
    const unsigned s = (unsigned)(c * w.nq + w.q) * CQ_BATCH;
    w.hw = s + (unsigned)(w.nq * CQ_BATCH);
    if (s < (unsigned)CQ_TOTAL) { w.lo = s; w.hi = s + CQ_BATCH; }
}
__device__ __forceinline__ void conv_drain(const Frame& F0, KP p, int E) {
    __syncthreads();
    const Frame F = relaunder(F0);
    LAS float* scr = (LAS float*)(F.lds + F.wave * 16384);
    ConvWave w = conv_wave((unsigned*)(p.ws + WS_CTL), F.lds, F.wave);
    for (;;) {
        while (w.lo < w.hi) { conv_item(p, (int)w.lo, scr, F.lane); ++w.lo; }
        if (w.hw >= (unsigned)E) break;
        conv_claim(w, F.lane);
    }
    conv_wave_save(w, F.wave);
}
__device__ __forceinline__ void xcd_barrier_steal(const XcdBarrier& b) {
    asm volatile("s_waitcnt vmcnt(0)" ::: "memory");
    if (threadIdx.x == 0) b.st[2] = 0u;
    __syncthreads();
    int t = threadIdx.x; asm volatile("" : "+v"(t));
    if (t == 0) {
        unsigned* bar = b.bar;
        __builtin_amdgcn_s_waitcnt(0);
        const unsigned nloc = b.st[0], nx = b.st[1];
        const unsigned old = xb_add(&bar[XB_XSUB(b.x)], 1u);
        const unsigned gen = old / nloc;
        if (old + 1u == (gen + 1u) * nloc) {
            __builtin_amdgcn_fence(__ATOMIC_RELEASE, "agent");
            asm volatile("s_waitcnt vmcnt(0)" ::: "memory");
            const unsigned og = xb_add(&bar[XB_TOP], 1u);
            const unsigned tg = og / nx;
            if (og + 1u == (tg + 1u) * nx) xb_add(&bar[XB_TOPGEN], 1u);
            else XB_SPIN(xb_ld(&bar[XB_TOPGEN]) == tg, bar);
            __builtin_amdgcn_fence(__ATOMIC_ACQUIRE, "agent");
            xb_add(&bar[XB_XGEN(b.x)], 1u);
            asm volatile("s_waitcnt vmcnt(0)" ::: "memory");
        } else {
            XB_SPIN(xb_ld(&bar[XB_XGEN(b.x)]) == gen, bar);
            __builtin_amdgcn_fence(__ATOMIC_ACQUIRE, "agent");
            asm volatile("s_waitcnt vmcnt(0)" ::: "memory");
        }
        b.st[2] = 1u;
    } else if (CQ_STEAL && t >= 64) {
        const int wave = __builtin_amdgcn_readfirstlane(t >> 6), lane = t & 63;
        LAS unsigned char* lds = (LAS unsigned char*)b.st - (MISC_OFF + 32);
        if (((volatile LAS unsigned*)(lds + MISC_OFF))[16 + wave] < (unsigned)CQ_TOTAL || ((volatile LAS unsigned*)(lds + MISC_OFF))[40 + 2 * wave] < ((volatile LAS unsigned*)(lds + MISC_OFF))[41 + 2 * wave]) {
            KP p = *kparams();
            LAS float* scr = (LAS float*)(lds + wave * 16384);
            ConvWave w = conv_wave(b.bar - CW_BAR, lds, wave);
            while (b.st[2] == 0u) {
                if (w.lo < w.hi) { conv_item(p, (int)w.lo, scr, lane); ++w.lo; continue; }
                if (w.hw >= (unsigned)CQ_TOTAL) break;
                conv_claim(w, lane);
            }
            conv_wave_save(w, wave);
        }
    }
    __syncthreads();
}
__device__ __forceinline__ void p0_prologue(const Frame& F0, KP p) {
    const Frame F = relaunder(F0);
    {
        LAS float* cact = (LAS float*)F.lds;
        LAS float* part = (LAS float*)(F.lds + 16384);
        float* MOD = (float*)(p.ws + WS_MOD);
        bool loaded = false;
        for (int task = blockIdx.x; task < DEPTH * 64; task += F.G) {
            if (!loaded) { for (int i = F.tid; i < NB * D; i += NTHREADS) { const float v = p.c[i]; cact[i] = silu_f(v); } loaded = true; __syncthreads(); }
            const int layer = task / 64, cg = task % 64, ksub = F.lane >> 5, cl = F.lane & 31, c0 = cg * 96 + 4 * (cl < 24 ? cl : 23);
            f32x4 a[NB];
#pragma unroll
            for (int b = 0; b < NB; ++b) a[b] = (f32x4){0.f, 0.f, 0.f, 0.f};
            const unsigned voff = (unsigned)(ksub * 6144 + c0) * 4u;
            const float* wrow = p.w_ada + ((size_t)layer * D + F.wave * 128) * 6144;
#define MOD_LD(u) asm volatile("global_load_dwordx4 %0, %1, %2" : "=&v"(wv[u]) : "v"(voff), "s"(wrow + (size_t)(2 * (i0 + (u))) * 6144) : "memory")
#define MOD_FMA(u) { asm volatile("s_waitcnt vmcnt(%1)" : "+v"(wv[u]) : "n"(15 - (u)) : "memory"); \
                _Pragma("unroll") for (int b = 0; b < NB; ++b) { const float cv = cact[b * D + F.wave * 128 + 2 * (i0 + (u)) + ksub]; a[b] = a[b] + wv[u] * cv; } }
            for (int i0 = 0; i0 < 64; i0 += 16) {
                f32x4 wv[16];
                MOD_LD(0); MOD_LD(1); MOD_LD(2); MOD_LD(3); MOD_LD(4); MOD_LD(5); MOD_LD(6); MOD_LD(7); MOD_LD(8); MOD_LD(9); MOD_LD(10); MOD_LD(11); MOD_LD(12); MOD_LD(13); MOD_LD(14); MOD_LD(15);
                MOD_FMA(0) MOD_FMA(1) MOD_FMA(2) MOD_FMA(3) MOD_FMA(4) MOD_FMA(5) MOD_FMA(6) MOD_FMA(7) MOD_FMA(8) MOD_FMA(9) MOD_FMA(10) MOD_FMA(11) MOD_FMA(12) MOD_FMA(13) MOD_FMA(14) MOD_FMA(15)
            }
#undef MOD_LD
#undef MOD_FMA
#pragma unroll
            for (int b = 0; b < NB; ++b) {
#pragma unroll
                for (int e = 0; e < 4; ++e) a[b][e] += __shfl_xor(a[b][e], 32);
                if (ksub == 0 && cl < 24) *(LAS f32x4*)(part + (F.wave * NB + b) * 128 + 4 * cl) = a[b]; }
            __syncthreads();
            { const int b = F.tid >> 7, col = F.tid & 127; float s = 0.f;
#pragma unroll
              for (int w = 0; w < NWAVES; ++w) s += part[(w * NB + b) * 128 + col];
              if (col < 96) MOD[((size_t)layer * NB + b) * 6144 + cg * 96 + col] = s + p.b_ada[(size_t)layer * 6144 + cg * 96 + col]; }
            __syncthreads();
        }
        __syncthreads();
    }
}

__device__ __forceinline__ void norm_phase(const Frame& F0, const float* xin, const float* ng, const float* modl  , int sh_off, int sc_off, bf16_t* H) {
    const Frame F = relaunder(F0);
    const int gw = F.vcu * NWAVES + F.wave, NGW = F.G * NWAVES;
    for (int rb = gw; rb < T / 16; rb += NGW) {
        const int row0 = rb * 16, b = row0 >> 13;
        f32x4 gs[4], sh[4];
#pragma unroll
        for (int j = 0; j < 4; ++j) { const int c = 4 * F.lane + 256 * j; const f32x4 g = *(const f32x4*)(ng + c), sc = *(const f32x4*)(modl + (size_t)b * 6144 + sc_off + c);
            gs[j] = g * (sc + 1.0f); sh[j] = *(const f32x4*)(modl + (size_t)b * 6144 + sh_off + c); }
        for (int r = 0; r < 16; ++r) {
            const float* xr = xin + (size_t)(row0 + r) * D + 4 * F.lane;
            f32x4 v[4]; float ss = 0.f;
#pragma unroll
            for (int j = 0; j < 4; ++j) { v[j] = *(const f32x4*)(xr + 256 * j); ss += (v[j].x * v[j].x + v[j].y * v[j].y) + (v[j].z * v[j].z + v[j].w * v[j].w); }
            const float rstd = 1.0f / sqrtf(wave_sum(ss) * (1.0f / D) + EPS);
            bf16_t* hr = H + (size_t)(row0 + r) * D + 4 * F.lane;
#pragma unroll
            for (int j = 0; j < 4; ++j) { const f32x4 o = v[j] * rstd * gs[j] + sh[j]; u32x2 w; w.x = cvt_pk_bf16(o.x, o.y); w.y = cvt_pk_bf16(o.z, o.w); *(u32x2*)(hr + 256 * j) = w; }
        }
    }
}
__device__ __forceinline__ void final_phase(const Frame& F0, float* x, const float* fg) {
    const Frame F = relaunder(F0);
    const int gw = F.vcu * NWAVES + F.wave, NGW = F.G * NWAVES;
    f32x4 g[4];
#pragma unroll
    for (int j = 0; j < 4; ++j) g[j] = *(const f32x4*)(fg + 4 * F.lane + 256 * j);
    for (int row = gw; row < T; row += NGW) {
        float* xr = x + (size_t)row * D + 4 * F.lane;
        f32x4 v[4]; float ss = 0.f;
#pragma unroll
        for (int j = 0; j < 4; ++j) { v[j] = *(const f32x4*)(xr + 256 * j); ss += (v[j].x * v[j].x + v[j].y * v[j].y) + (v[j].z * v[j].z + v[j].w * v[j].w); }
        const float rstd = 1.0f / sqrtf(wave_sum(ss) * (1.0f / D) + EPS);
#pragma unroll
        for (int j = 0; j < 4; ++j) *(f32x4*)(xr + 256 * j) = v[j] * rstd * g[j];
    }
}

typedef f32x4 AccT[2][2][4][2];
__device__ __forceinline__ void st8(bf16_t* p, const f32x4& v0, const f32x4& v1) {
    u32x4 w; w.x = cvt_pk_bf16(v0.x, v0.y); w.y = cvt_pk_bf16(v0.z, v0.w); w.z = cvt_pk_bf16(v1.x, v1.y); w.w = cvt_pk_bf16(v1.z, v1.w); *(u32x4*)p = w;
}
__device__ __forceinline__ void st8_sc1(bf16_t* p, const f32x4& v0, const f32x4& v1) {
    u32x4 w; w.x = cvt_pk_bf16(v0.x, v0.y); w.y = cvt_pk_bf16(v0.z, v0.w); w.z = cvt_pk_bf16(v1.x, v1.y); w.w = cvt_pk_bf16(v1.z, v1.w);
    asm volatile("global_store_dwordx4 %0, %1, off sc1\n\ts_nop 1" :: "v"(p), "v"(w) : "memory");
}
struct EpiRetIn {
    static constexpr bool PERM = true;
    bf16_t* O;
    __device__ __forceinline__ void operator()(const AccT& acc, const pg8::Unit& u, int wr, int wc, int fr, int fq) const {
        const int row0 = u.pm * 256 + wr * 64 + fr, col0 = u.pn * 256 + wc * 32 + 8 * fq;
        if (u.pn < 8) {
            const float osc = (u.pn >= 4) ? 0.0625f : 1.0f;
            float invf[8];
#pragma unroll
            for (int q = 0; q < 8; ++q) invf[q] = INVF_REV[wc * 32 + 8 * fq + q];
#pragma unroll
            for (int ai = 0; ai < 2; ++ai)
#pragma unroll
                for (int m = 0; m < 4; ++m) { const int row = row0 + ai * 128 + m * 16; const float pos = (float)(row & (SEQ - 1));
                    f32x4 o1[2], o2[2];
#pragma unroll
                    for (int n = 0; n < 2; ++n)
#pragma unroll
                        for (int j = 0; j < 4; ++j) { float rev = pos * invf[n * 4 + j]; rev -= floorf(rev);
                            const float sn = __builtin_amdgcn_sinf(rev), cs = __builtin_amdgcn_cosf(rev);
                            const float x1 = acc[ai][0][m][n][j], x2 = acc[ai][1][m][n][j];
                            o1[n][j] = (x1 * cs - x2 * sn) * osc; o2[n][j] = (x1 * sn + x2 * cs) * osc; }
                    bf16_t* rp = O + (size_t)row * RET_IN + col0;
                    st8(rp, o1[0], o1[1]); st8(rp + 128, o2[0], o2[1]); }
        } else {
#pragma unroll
            for (int ai = 0; ai < 2; ++ai)
#pragma unroll
                for (int m = 0; m < 4; ++m) { bf16_t* rp = O + (size_t)(row0 + ai * 128 + m * 16) * RET_IN + col0;
                    st8(rp, acc[ai][0][m][0], acc[ai][0][m][1]); st8(rp + 128, acc[ai][1][m][0], acc[ai][1][m][1]); }
        }
    }
};
struct EpiGmIn {
    static constexpr bool PERM = true;
    bf16_t* O; float* stat;
    template <bool VH>
    __device__ __forceinline__ void body(const AccT& acc, const pg8::Unit& u, int wr, int wc, int fr, int fq) const {
        const int row0 = u.pm * 256 + wr * 64 + fr, col0 = u.pn * 256 + wc * 32 + 8 * fq;
#pragma unroll
        for (int ai = 0; ai < 2; ++ai)
#pragma unroll
            for (int m = 0; m < 4; ++m) { const int row = row0 + ai * 128 + m * 16; bf16_t* rp = O + (size_t)row * GM_FFN + col0; float s1 = 0.f, s2 = 0.f;
#pragma unroll
                for (int bj = 0; bj < 2; ++bj) { f32x4 v[2];
#pragma unroll
                    for (int n = 0; n < 2; ++n) { const f32x4 a = acc[ai][bj][m][n]; const f32x2 g0 = pg8::gelu_pk((f32x2){a.x, a.y}), g1 = pg8::gelu_pk((f32x2){a.z, a.w}); v[n] = (f32x4){g0.x, g0.y, g1.x, g1.y};
                        if constexpr (VH) { s1 += (g0.x + g0.y) + (g1.x + g1.y); s2 += (g0.x * g0.x + g0.y * g0.y) + (g1.x * g1.x + g1.y * g1.y); } }
                    st8(rp + bj * 128, v[0], v[1]); }
                if constexpr (VH) { s1 += __shfl_xor(s1, 16); s1 += __shfl_xor(s1, 32); s2 += __shfl_xor(s2, 16); s2 += __shfl_xor(s2, 32);
                    if (fq == 0) *(f32x2*)(stat + ((size_t)((u.pn - 12) * 4 + wc) * T + row) * 2) = (f32x2){s1, s2}; } }
    }
    __device__ __forceinline__ void operator()(const AccT& acc, const pg8::Unit& u, int wr, int wc, int fr, int fq) const {
        if (u.pn >= 12) body<true>(acc, u, wr, wc, fr, fq); else body<false>(acc, u, wr, wc, fr, fq);
    }
};
struct EpiNaIn {
    static constexpr bool PERM = true;
    bf16_t* O;
    __device__ __forceinline__ void operator()(const AccT& acc, const pg8::Unit& u, int wr, int wc, int fr, int fq) const {
        const int row0 = u.pm * 256 + wr * 64 + fr, col0 = u.pn * 256 + wc * 32 + 8 * fq;
        const float sc = (u.pn < 4) ? 0.17677669529663687f * LOG2E : 1.0f;
#pragma unroll
        for (int ai = 0; ai < 2; ++ai)
#pragma unroll
            for (int m = 0; m < 4; ++m) { bf16_t* rp = O + (size_t)(row0 + ai * 128 + m * 16) * 3072 + col0;
                st8(rp, acc[ai][0][m][0] * sc, acc[ai][0][m][1] * sc); st8(rp + 128, acc[ai][1][m][0] * sc, acc[ai][1][m][1] * sc); }
    }
};
struct EpiResid {
    static constexpr bool PERM = false;
    const float* xin; float* xout; const float* g;
    __device__ __forceinline__ void operator()(const AccT& acc, const pg8::Unit& u, int wr, int wc, int fr, int fq) const {
        const int row0 = u.pm * 256 + wr * 64 + fr, col0 = u.pn * 256 + wc * 32 + 4 * fq, b = (u.pm * 256) >> 13;
        f32x4 gv[2][2];
#pragma unroll
        for (int bj = 0; bj < 2; ++bj)
#pragma unroll
            for (int n = 0; n < 2; ++n) gv[bj][n] = *(const f32x4*)(g + (size_t)b * 6144 + col0 + bj * 128 + n * 16);
#pragma unroll
        for (int ai = 0; ai < 2; ++ai)
#pragma unroll
            for (int m = 0; m < 4; ++m) { const size_t off = (size_t)(row0 + ai * 128 + m * 16) * D + col0;
#pragma unroll
                for (int bj = 0; bj < 2; ++bj)
#pragma unroll
                    for (int n = 0; n < 2; ++n) { const f32x4 xv = *(const f32x4*)(xin + off + bj * 128 + n * 16); *(f32x4*)(xout + off + bj * 128 + n * 16) = xv + gv[bj][n] * acc[ai][bj][m][n]; } }
    }
};
#define EP_LD(dst, ptr) asm volatile("global_load_dwordx4 %0, %1, off" : "=&v"(dst) : "v"(ptr) : "memory")
#define EP_ST(ptr, val) asm volatile("global_store_dwordx4 %0, %1, off\n\ts_nop 1" :: "v"(ptr), "v"(val) : "memory")
#define EP_WAIT4(N, q) asm volatile("s_waitcnt vmcnt(" #N ")" : "+v"(q[0]), "+v"(q[1]), "+v"(q[2]), "+v"(q[3]) :: "memory")
struct EpiMoeGU {
    static constexpr bool PERM = true;
    bf16_t* hid; const float* tok_wa; const float* tok_wb; unsigned* done; bf16_t* dummy;
    __device__ __forceinline__ void operator()(const AccT& acc, const pg8::Unit& u, int wr, int wc, int fr, int fq) const {
        const int r0 = wr * 64 + fr, col0 = (u.pn >> 2) * 512 + (u.pn & 3) * 128 + wc * 32 + 8 * fq, nv1 = u.nvalid - 1;
        const float* wsel = (u.pn < 4) ? tok_wa : tok_wb;
        int tok[2][4]; float w[2][4];
#pragma unroll
        for (int ai = 0; ai < 2; ++ai)
#pragma unroll
            for (int m = 0; m < 4; ++m) { const int r = r0 + ai * 128 + m * 16; tok[ai][m] = u.rt[r < nv1 ? r : nv1]; }
#pragma unroll
        for (int ai = 0; ai < 2; ++ai)
#pragma unroll
            for (int m = 0; m < 4; ++m) w[ai][m] = wsel[tok[ai][m]];
#pragma unroll
        for (int ai = 0; ai < 2; ++ai)
#pragma unroll
            for (int m = 0; m < 4; ++m) { const int r = r0 + ai * 128 + m * 16; f32x4 v[2];
#pragma unroll
                for (int n = 0; n < 2; ++n)
#pragma unroll
                    for (int j = 0; j < 4; ++j) v[n][j] = w[ai][m] * silu_f(acc[ai][0][m][n][j]) * acc[ai][1][m][n][j];
                st8_sc1((r <= nv1 ? hid + (size_t)tok[ai][m] * 1024 : dummy) + col0, v[0], v[1]); }
        asm volatile("s_waitcnt vmcnt(0)" ::: "memory");
        if (fr == 0 && fq == 0) (void)__hip_atomic_fetch_add(done + u.pm, 1u, __ATOMIC_RELAXED, __HIP_MEMORY_SCOPE_AGENT);
    }
};
struct EpiMoeDown {
    static constexpr bool PERM = false;
    float* x; const LAS float* gl; float* dummy;
    __device__ __forceinline__ void operator()(const AccT& acc, const pg8::Unit& u, int wr, int wc, int fr, int fq) const {
        const int r0 = wr * 64 + fr, col0 = u.pn * 256 + wc * 32 + 4 * fq, nv1 = u.nvalid - 1;
        int tok[2][4];
#pragma unroll
        for (int ai = 0; ai < 2; ++ai)
#pragma unroll
            for (int m = 0; m < 4; ++m) { const int r = r0 + ai * 128 + m * 16; tok[ai][m] = u.rt[r < nv1 ? r : nv1]; }
#pragma unroll
        for (int g2 = 0; g2 < 4; ++g2) {
            const int ai = g2 >> 1, mb = (g2 & 1) * 2;
            float* xr[2]; f32x4 xv[2][4];
#pragma unroll
            for (int mm = 0; mm < 2; ++mm) { const int m = mb + mm; xr[mm] = ((r0 + ai * 128 + m * 16 <= nv1) ? x + (size_t)tok[ai][m] * D : dummy) + col0;
}
            asm volatile("global_load_dwordx4 %0, %8, off\n\tglobal_load_dwordx4 %1, %8, off offset:64\n\tglobal_load_dwordx4 %2, %8, off offset:512\n\tglobal_load_dwordx4 %3, %8, off offset:576\n\t"
                         "global_load_dwordx4 %4, %9, off\n\tglobal_load_dwordx4 %5, %9, off offset:64\n\tglobal_load_dwordx4 %6, %9, off offset:512\n\tglobal_load_dwordx4 %7, %9, off offset:576\n\t"
                         "s_waitcnt vmcnt(0)"
                         : "=&v"(xv[0][0]), "=&v"(xv[0][1]), "=&v"(xv[0][2]), "=&v"(xv[0][3]), "=&v"(xv[1][0]), "=&v"(xv[1][1]), "=&v"(xv[1][2]), "=&v"(xv[1][3]) : "v"(xr[0]), "v"(xr[1]) : "memory");
#pragma unroll
            for (int mm = 0; mm < 2; ++mm) { const int m = mb + mm; const LAS float* gp = gl + (tok[ai][m] >> 13) * 1024 + col0;
#pragma unroll
                for (int j = 0; j < 4; ++j) { const f32x4 gv = *(const LAS f32x4*)(gp + (j >> 1) * 128 + (j & 1) * 16); xv[mm][j] = xv[mm][j] + gv * acc[ai][j >> 1][m][j & 1]; } }
#pragma unroll
            for (int mm = 0; mm < 2; ++mm)
#pragma unroll
                for (int j = 0; j < 4; ++j) EP_ST(xr[mm] + (j >> 1) * 128 + (j & 1) * 16, xv[mm][j]);
        }
    }
};

__device__ __forceinline__ float second_of4_sum(float a, float b, float c, float d) {
    const float hi1 = fmaxf(a, b), lo1 = fminf(a, b), hi2 = fmaxf(c, d), lo2 = fminf(c, d);
    return fmaxf(hi1, hi2) + fmaxf(fminf(hi1, hi2), fmaxf(lo1, lo2));
}
__device__ __forceinline__ void moe_route_phase(const Frame& F0, KP p, int layer, const float* x) {
    const Frame F = relaunder(F0);
    constexpr int BP = 1028;
    LAS float* BpT = (LAS float*)F.lds;
    LAS float* cb = (LAS float*)(F.lds + 16 * BP * 4);
    LAS int* tcls = (LAS int*)(F.lds + 16 * BP * 4 + 128);
    LAS int* cbase = (LAS int*)(F.lds + 16 * BP * 4 + 128 + 512);
    LAS float* Lt = (LAS float*)(F.lds + 16 * BP * 4 + 1024) + F.wave * 256;
    const float* modl = (const float*)(p.ws + WS_MOD) + (size_t)layer * NB * 6144;
    const float* ng = p.norm_g + (size_t)(layer * 2 + 1) * D;
    unsigned* cnt = (unsigned*)(p.ws + WS_CTL) + CW_MOECNT + layer * 32;
    float* tok_wa = (float*)(p.ws + WS_TOK); float* tok_wb = tok_wa + T;
    int* rowtok = (int*)(p.ws + WS_ROWTOK);
    bf16_t* h2 = (bf16_t*)(p.ws + WS_H2);
    const int lane = F.lane, n16 = lane & 15, g = lane >> 4;
    int built_b = -1;
    for (int chunk = blockIdx.x; chunk < T / 128; chunk += F.G) {
        const int b = chunk >> 6;
        if (b != built_b) {
            for (int k = F.tid; k < D; k += NTHREADS) { const float gs = ng[k] * (1.0f + modl[(size_t)b * 6144 + MOD_SC2 + k]);
#pragma unroll
                for (int q = 0; q < 4; ++q) { const f32x4 r = *(const f32x4*)(p.router_w + (size_t)k * 16 + 4 * q);
                    BpT[(4 * q + 0) * BP + k] = gs * r.x; BpT[(4 * q + 1) * BP + k] = gs * r.y; BpT[(4 * q + 2) * BP + k] = gs * r.z; BpT[(4 * q + 3) * BP + k] = gs * r.w; } }
            {
                float shv[16]; f32x2 rw[16];
#pragma unroll
                for (int i = 0; i < 16; ++i) { const int k = F.lane + 64 * i; shv[i] = modl[(size_t)b * 6144 + MOD_SH2 + k]; rw[i] = *(const f32x2*)(p.router_w + (size_t)k * 16 + 2 * F.wave); }
                float s0 = 0.f, s1 = 0.f;
#pragma unroll
                for (int i = 0; i < 16; ++i) { s0 += shv[i] * rw[i].x; s1 += shv[i] * rw[i].y; }
                s0 = wave_sum(s0); s1 = wave_sum(s1); if (F.lane == 0) { cb[2 * F.wave] = s0; cb[2 * F.wave + 1] = s1; }
            }
            built_b = b;
        }
        __syncthreads();
        const int tokb = chunk * 128 + F.wave * 16;
        f32x4 acc0 = {0.f, 0.f, 0.f, 0.f}, acc1 = {0.f, 0.f, 0.f, 0.f}; float ss = 0.f;
        {
            const float* xp = x + (size_t)(tokb + n16) * D + 4 * g; const LAS float* bp = BpT + n16 * BP + 4 * g;
#define RT_LD(S, u) asm volatile("global_load_dwordx4 %0, %1, off offset:%2" : "=&v"(xa[S][u]) : "v"(xq), "n"(64 * (u)) : "memory")
#define RT_LD16(S) do { RT_LD(S, 0); RT_LD(S, 1); RT_LD(S, 2); RT_LD(S, 3); RT_LD(S, 4); RT_LD(S, 5); RT_LD(S, 6); RT_LD(S, 7); RT_LD(S, 8); RT_LD(S, 9); RT_LD(S, 10); RT_LD(S, 11); RT_LD(S, 12); RT_LD(S, 13); RT_LD(S, 14); RT_LD(S, 15); } while (0)
#define RT_USE(S, u, PEND) do { asm volatile("s_waitcnt vmcnt(%1)" : "+v"(xa[S][u]) : "n"((PEND) + 15 - (u)) : "memory"); const f32x4 xv_ = xa[S][u]; const f32x4 wb = *(const LAS f32x4*)(bq + 16 * (u)); \
                ss += (xv_.x * xv_.x + xv_.y * xv_.y) + (xv_.z * xv_.z + xv_.w * xv_.w); \
                acc0 = __builtin_amdgcn_mfma_f32_16x16x4f32(xv_.x, wb.x, acc0, 0, 0, 0); acc1 = __builtin_amdgcn_mfma_f32_16x16x4f32(xv_.y, wb.y, acc1, 0, 0, 0); \
                acc0 = __builtin_amdgcn_mfma_f32_16x16x4f32(xv_.z, wb.z, acc0, 0, 0, 0); acc1 = __builtin_amdgcn_mfma_f32_16x16x4f32(xv_.w, wb.w, acc1, 0, 0, 0); } while (0)
#define RT_USE16(S, PEND) do { RT_USE(S, 0, PEND); RT_USE(S, 1, PEND); RT_USE(S, 2, PEND); RT_USE(S, 3, PEND); RT_USE(S, 4, PEND); RT_USE(S, 5, PEND); RT_USE(S, 6, PEND); RT_USE(S, 7, PEND); \
                RT_USE(S, 8, PEND); RT_USE(S, 9, PEND); RT_USE(S, 10, PEND); RT_USE(S, 11, PEND); RT_USE(S, 12, PEND); RT_USE(S, 13, PEND); RT_USE(S, 14, PEND); RT_USE(S, 15, PEND); } while (0)
            f32x4 xa[2][16];
            const float* xq = xp; const LAS float* bq = bp;
            RT_LD16(0);
            xq = xp + 256; RT_LD16(1); RT_USE16(0, 16); bq = bp + 256;
            xq = xp + 512; RT_LD16(0); RT_USE16(1, 16); bq = bp + 512;
            xq = xp + 768; RT_LD16(1); RT_USE16(0, 16); bq = bp + 768;
            RT_USE16(1, 0);
#undef RT_LD
#undef RT_LD16
#undef RT_USE
#undef RT_USE16
        }
        ss += __shfl_xor(ss, 16); ss += __shfl_xor(ss, 32);
        const float rstd_l = 1.0f / sqrtf(ss * (1.0f / D) + EPS);
        {
            const f32x4 acc = acc0 + acc1; const float cbe = cb[n16];
#pragma unroll
            for (int i = 0; i < 4; ++i) { const float rs = __shfl(rstd_l, 4 * g + i); Lt[(4 * g + i) * 16 + n16] = rs * acc[i] + cbe; }
        }
        LDS_WAIT();
        if (lane < 16) {
            float sc[16], bi[16];
#pragma unroll
            for (int q = 0; q < 4; ++q) { const f32x4 lv = *(const LAS f32x4*)(Lt + lane * 16 + 4 * q);
#pragma unroll
                for (int jj = 0; jj < 4; ++jj) { const int e = 4 * q + jj; sc[e] = 1.0f / (1.0f + __expf(-lv[jj])); bi[e] = sc[e] + p.router_b[e]; } }
            float gsum[4];
#pragma unroll
            for (int gg = 0; gg < 4; ++gg) gsum[gg] = second_of4_sum(bi[4 * gg], bi[4 * gg + 1], bi[4 * gg + 2], bi[4 * gg + 3]);
            int grp = 0; float best = gsum[0];
#pragma unroll
            for (int gg = 1; gg < 4; ++gg) if (gsum[gg] > best) { best = gsum[gg]; grp = gg; }
            float vb[4], vs[4];
#pragma unroll
            for (int q = 0; q < 4; ++q) { vb[q] = grp == 0 ? bi[q] : grp == 1 ? bi[4 + q] : grp == 2 ? bi[8 + q] : bi[12 + q]; vs[q] = grp == 0 ? sc[q] : grp == 1 ? sc[4 + q] : grp == 2 ? sc[8 + q] : sc[12 + q]; }
            int i1 = 0; float m1 = vb[0];
#pragma unroll
            for (int q = 1; q < 4; ++q) if (vb[q] > m1) { m1 = vb[q]; i1 = q; }
            int i2 = -1; float m2 = -3.0e38f;
#pragma unroll
            for (int q = 0; q < 4; ++q) if (q != i1 && vb[q] > m2) { m2 = vb[q]; i2 = q; }
            const int la = i1 < i2 ? i1 : i2, lb = i1 < i2 ? i2 : i1;
            const float sa = la == 0 ? vs[0] : la == 1 ? vs[1] : vs[2], sb = lb == 1 ? vs[1] : lb == 2 ? vs[2] : vs[3];
            const float inv = 1.0f / (sa + sb);
            const int pi = la == 0 ? lb - 1 : la == 1 ? lb + 1 : 5;
            tcls[F.wave * 16 + lane] = grp * 6 + pi; tok_wa[tokb + lane] = sa * inv; tok_wb[tokb + lane] = sb * inv;
        }
        {
            f32x4 gs4[4], sh4[4];
#pragma unroll
            for (int j = 0; j < 4; ++j) { const int cc = 4 * lane + 256 * j; const f32x4 gv = *(const f32x4*)(ng + cc), scv = *(const f32x4*)(modl + (size_t)b * 6144 + MOD_SC2 + cc);
                gs4[j] = gv * (scv + 1.0f); sh4[j] = *(const f32x4*)(modl + (size_t)b * 6144 + MOD_SH2 + cc); }
#pragma unroll
            for (int rb = 0; rb < 4; ++rb) {
                f32x4 v[4][4];
                const float* q0 = x + (size_t)(tokb + 4 * rb) * D + 4 * lane; const float* q1 = q0 + D; const float* q2 = q0 + 2 * D; const float* q3 = q0 + 3 * D;
                asm volatile("global_load_dwordx4 %0, %16, off\n\tglobal_load_dwordx4 %1, %16, off offset:1024\n\tglobal_load_dwordx4 %2, %16, off offset:2048\n\tglobal_load_dwordx4 %3, %16, off offset:3072\n\t"
                             "global_load_dwordx4 %4, %17, off\n\tglobal_load_dwordx4 %5, %17, off offset:1024\n\tglobal_load_dwordx4 %6, %17, off offset:2048\n\tglobal_load_dwordx4 %7, %17, off offset:3072\n\t"
                             "global_load_dwordx4 %8, %18, off\n\tglobal_load_dwordx4 %9, %18, off offset:1024\n\tglobal_load_dwordx4 %10, %18, off offset:2048\n\tglobal_load_dwordx4 %11, %18, off offset:3072\n\t"
                             "global_load_dwordx4 %12, %19, off\n\tglobal_load_dwordx4 %13, %19, off offset:1024\n\tglobal_load_dwordx4 %14, %19, off offset:2048\n\tglobal_load_dwordx4 %15, %19, off offset:3072\n\t"
                             "s_waitcnt vmcnt(0)"
                             : "=&v"(v[0][0]), "=&v"(v[0][1]), "=&v"(v[0][2]), "=&v"(v[0][3]), "=&v"(v[1][0]), "=&v"(v[1][1]), "=&v"(v[1][2]), "=&v"(v[1][3]),
                               "=&v"(v[2][0]), "=&v"(v[2][1]), "=&v"(v[2][2]), "=&v"(v[2][3]), "=&v"(v[3][0]), "=&v"(v[3][1]), "=&v"(v[3][2]), "=&v"(v[3][3])
                             : "v"(q0), "v"(q1), "v"(q2), "v"(q3) : "memory");
#pragma unroll
                for (int rr = 0; rr < 4; ++rr) { const int r = 4 * rb + rr;
                    const float rstd = __builtin_bit_cast(float, __builtin_amdgcn_readlane(__builtin_bit_cast(int, rstd_l), r));
                    bf16_t* hr = h2 + (size_t)(tokb + r) * D + 4 * lane;
#pragma unroll
                    for (int j = 0; j < 4; ++j) { const f32x4 o = v[rr][j] * rstd * gs4[j] + sh4[j]; u32x2 wq; wq.x = cvt_pk_bf16(o.x, o.y); wq.y = cvt_pk_bf16(o.z, o.w); *(u32x2*)(hr + 256 * j) = wq; } }
            }
        }
        __syncthreads();
        if (F.tid < NCLS) { int n = 0; for (int jj = 0; jj < 128; ++jj) n += (tcls[jj] == F.tid) ? 1 : 0; cbase[F.tid] = n ? (int)atomicAdd(cnt + F.tid, (unsigned)n) : 0; }
        __syncthreads();
        if (F.tid < 128) { const int cls = tcls[F.tid]; int rank = 0; for (int jj = 0; jj < F.tid; ++jj) rank += (tcls[jj] == cls) ? 1 : 0;
            rowtok[(size_t)cls * T + cbase[cls] + rank] = chunk * 128 + F.tid; }
        __syncthreads();
    }
}
struct MoeSched {
    int G, c, NP, NT; const LAS int* tile_cls; const char* Abase; const char* Wbase; size_t wmat, bntile; const int* rowtok; const unsigned* cnt; unsigned* done; unsigned* tmo;
    __device__ bool next(int i, pg8::Unit& u) const {
        const int nq = (G % 8 == 0) ? 8 : 1, Gq = G / nq, q = c / Gq, nrt = NT / nq + (q < NT % nq ? 1 : 0), rt0 = q * (NT / nq) + (q < NT % nq ? q : NT % nq);
        int j = c % Gq;
        if (done != nullptr) { j -= (8 * nrt) % Gq; if (j < 0) j += Gq; }
        const int Lq = j + Gq * i;
        if (Lq >= NP * nrt) return false;
        const int rt = rt0 + Lq / NP, pn = Lq % NP;
        if (done != nullptr) {
            int t = threadIdx.x; asm volatile("" : "+v"(t));
            if ((t & 63) == 0) { unsigned sp = 0u; while (__hip_atomic_load(done + rt, __ATOMIC_RELAXED, __HIP_MEMORY_SCOPE_AGENT) < 64u) { __builtin_amdgcn_s_sleep(2);
                if ((++sp & 255u) == 0u) { if (__hip_atomic_load(tmo, __ATOMIC_RELAXED, __HIP_MEMORY_SCOPE_AGENT)) break; if (sp > (1u << 22)) { atomicAdd(tmo, 1u); break; } } } }
        }
        const int tc = tile_cls[rt], cls = tc >> 8, kblk = tc & 255, grp = cls / 6, pi = cls % 6;
        const int la = pi < 3 ? 0 : (pi < 5 ? 1 : 2), lb = pi < 3 ? pi + 1 : (pi < 5 ? pi - 1 : 3);
        const int ea = grp * 4 + la, eb = grp * 4 + lb;
        u.pm = rt; u.pn = pn; u.aux = 0; u.A = Abase; u.rt = rowtok + (size_t)cls * T + kblk * 256;
        u.nvalid = tile_cls[512 + rt];
        if (NP == 8) { const int e = pn < 4 ? ea : eb; u.B = Wbase + (size_t)e * wmat + (size_t)(pn & 3) * bntile; u.B2 = u.B; }
        else { u.B = Wbase + (size_t)ea * wmat + (size_t)pn * bntile; u.B2 = Wbase + (size_t)eb * wmat + (size_t)pn * bntile; }
        return true;
    }
};
__device__ __forceinline__ int moe_tile_table(const Frame& F, const unsigned* cnt, LAS int* tab, const float* g2, LAS float* gl) {
    { int t = threadIdx.x; asm volatile("" : "+v"(t)); int cv = 0; if (t < NCLS) cv = (int)__hip_atomic_load(cnt + t, __ATOMIC_RELAXED, __HIP_MEMORY_SCOPE_AGENT);
      for (int i = t; i < NB * 256; i += NTHREADS) *(LAS f32x4*)(gl + (i >> 8) * 1024 + (i & 255) * 4) = *(const f32x4*)(g2 + (size_t)(i >> 8) * 6144 + (i & 255) * 4);
      if (t < NCLS) tab[768 + t] = cv; }
    __syncthreads();
    { int t = threadIdx.x; asm volatile("" : "+v"(t));
      if (t < NCLS) { int off = 0; for (int c = 0; c < t; ++c) off += (tab[768 + c] + 255) >> 8;
          const int n = tab[768 + t], nt = (n + 255) >> 8;
          for (int k = 0; k < nt; ++k) { tab[512 + off + k] = (n - k * 256) < 256 ? (n - k * 256) : 256; tab[off + k] = (t << 8) | k; }
          if (t == NCLS - 1) tab[255] = off + nt; } }
    __syncthreads();
    return tab[255];
}

#define TR2(lo, hi, base, OFF0, OFF1) asm volatile("ds_read_b64_tr_b16 %0, %2 offset:%3\n\tds_read_b64_tr_b16 %1, %2 offset:%4" : "=&v"(lo), "=&v"(hi) : "v"(base), "i"(OFF0), "i"(OFF1) : "memory")
#define RD128(dst, base, OFF) asm volatile("ds_read_b128 %0, %1 offset:%2" : "=&v"(dst) : "v"(base), "i"(OFF) : "memory")
#define LGKM_WAIT6(N, a, b, c, d, e, f) asm volatile("s_waitcnt lgkmcnt(" #N ")" : "+v"(a), "+v"(b), "+v"(c), "+v"(d), "+v"(e), "+v"(f) :: "memory")
#define LGKM_WAIT4(N, a, b, c, d) asm volatile("s_waitcnt lgkmcnt(" #N ")" : "+v"(a), "+v"(b), "+v"(c), "+v"(d) :: "memory")
#define GLD128(dst, ptr) asm volatile("global_load_dwordx4 %0, %1, off" : "=&v"(dst) : "v"(ptr) : "memory")
#define RAW_BARRIER() do { asm volatile("s_waitcnt lgkmcnt(0)" ::: "memory"); __builtin_amdgcn_s_barrier(); asm volatile("" ::: "memory"); } while (0)
__device__ __forceinline__ float log2_gamma(const float* decay_logit) {
    const float xv = *decay_logit; return -log1pf(__expf(-xv)) * LOG2E;
}
__device__ __forceinline__ u32x2 pack4(float a, float b, float c, float d) { u32x2 w; w.x = cvt_pk_bf16(a, b); w.y = cvt_pk_bf16(c, d); return w; }
__device__ __forceinline__ void ret_chain_phase(const Frame& F0, KP p, int j) {
    const Frame F = relaunder(F0);
    constexpr int PQ = 528, KSLOT = 32768, VSLOT = 8192;
    LAS unsigned char* bufK = F.lds; LAS unsigned char* bufV = F.lds + 3 * KSLOT; LAS unsigned char* ST = bufV + 3 * VSLOT;
    const bf16_t* PROJ = (const bf16_t*)(p.ws + WS_PROJ);
    const int lane = F.lane, w = F.wave, l32 = lane & 31, hh = lane >> 5, blk = (lane >> 4) & 1, q4 = (lane & 15) >> 2, p4 = lane & 3, n16 = lane & 15, g = lane >> 4;
    unsigned kdoff[4];
#pragma unroll
    for (int i = 0; i < 4; ++i) { const int row = 2 * (4 * w + i) + (lane >> 5); kdoff[i] = (unsigned)(row * RET_IN + (((lane & 31) ^ (4 * (row & 3))) * 8)) * 2u; }
    const int vrow = F.tid >> 3, vchk = F.tid & 7;
    const unsigned vdoff = (unsigned)(vrow * RET_IN + vchk * 8) * 2u;
    const int vlds = vrow * 128 + ((vchk ^ (4 * ((vrow >> 1) & 1))) * 16);
    const int kch = (4 * w + 2 * blk + (p4 >> 1)) ^ (4 * q4);
    const int aKoff = (8 * hh + q4) * 512 + kch * 16 + (p4 & 1) * 8;
    const int vch0 = (2 * blk + (p4 >> 1)) ^ (4 * ((q4 >> 1) & 1)), vch1 = (4 + 2 * blk + (p4 >> 1)) ^ (4 * ((q4 >> 1) & 1));
    const int aV0off = (8 * hh + q4) * 128 + vch0 * 16 + (p4 & 1) * 8, aV1off = (8 * hh + q4) * 128 + vch1 * 16 + (p4 & 1) * 8;
    for (int chain = F.vcu; chain < 256; chain += F.G) {
        const int b = chain >> 6, h = (chain >> 4) & 3, dir = (chain >> 3) & 1, sl = chain & 7;
        const float lg2 = log2_gamma(p.ret_decay + (size_t)j * 8 + dir * 4 + h);
        bf16_t* CROSS = (bf16_t*)(p.ws + (dir ? WS_CROSSB : WS_CROSSF));
        const float dec = fast_exp2(lg2 * 128.0f);
        f32x16 sacc[2]; sacc[0] = zero16(); sacc[1] = zero16();
        bf16x8 qa[8], qb[8];
        const int c16 = 16 * w + n16;
        const size_t qoff = (size_t)c16 * RET_IN + h * 256 + 8 * g;
        const float xi = dir ? fast_exp2(lg2 * (float)(128 - c16)) : fast_exp2(lg2 * (float)(c16 + 1));
        const float zs = dir ? lg2 : -lg2, z0 = dir ? 0.f : lg2 * 127.0f;
        const float zv0 = fast_exp2(zs * (float)vrow + z0), zv1 = fast_exp2(zs * (float)(64 + vrow) + z0);
        u32x4 vA, vB;
        const bf16_t* kbase = PROJ + (size_t)b * SEQ * RET_IN + 1024 + h * 256;
        const bf16_t* vbase = PROJ + (size_t)b * SEQ * RET_IN + 2048 + h * 512 + sl * 64;
#define CH_ISSUE(hs_) do { const int st_ = (hs_) >> 1, hf_ = (hs_) & 1, n_ = dir ? 63 - st_ : st_, sl3_ = (hs_) % 3; \
            const char* kg_ = (const char*)(kbase + ((size_t)n_ * 128 + 64 * hf_) * RET_IN); const char* vg_ = (const char*)(vbase + ((size_t)n_ * 128 + 64 * hf_) * RET_IN); \
            _Pragma("unroll") for (int i_ = 0; i_ < 4; ++i_) __builtin_amdgcn_global_load_lds((const unsigned*)(kg_ + kdoff[i_]), (LAS unsigned*)(bufK + sl3_ * KSLOT + (4 * w + i_) * 1024), 16, 0, 0); (void)vg_; } while (0)
#define CH_LOADV(hs_, VR) do { const int st_ = (hs_) >> 1, hf_ = (hs_) & 1, n_ = dir ? 63 - st_ : st_; \
            GLD128(VR, (const char*)(vbase + ((size_t)n_ * 128 + 64 * hf_) * RET_IN) + vdoff); } while (0)
#define CH_WRITEV(hs_, VR) do { const float z_ = ((hs_) & 1) ? zv1 : zv0; u32x4 o_; \
            o_.x = cvt_pk_bf16(bf_lo(VR.x) * z_, bf_hi(VR.x) * z_); o_.y = cvt_pk_bf16(bf_lo(VR.y) * z_, bf_hi(VR.y) * z_); o_.z = cvt_pk_bf16(bf_lo(VR.z) * z_, bf_hi(VR.z) * z_); o_.w = cvt_pk_bf16(bf_lo(VR.w) * z_, bf_hi(VR.w) * z_); \
            *(LAS u32x4*)(bufV + ((hs_) % 3) * VSLOT + vlds) = o_; } while (0)
#define CH_RDK(ks_, kl, kh, al, ah, bl, bh) do { TR2(kl, kh, aKb, (16 * (ks_)) * 512, (16 * (ks_) + 4) * 512); TR2(al, ah, aV0b, (16 * (ks_)) * 128, (16 * (ks_) + 4) * 128); TR2(bl, bh, aV1b, (16 * (ks_)) * 128, (16 * (ks_) + 4) * 128); } while (0)
#define CH_MM(kl, kh, al, ah, bl, bh) do { const bf16x8 ka_ = __builtin_shufflevector(kl, kh, 0, 1, 2, 3, 4, 5, 6, 7); \
            sacc[0] = MFMA32(ka_, __builtin_shufflevector(al, ah, 0, 1, 2, 3, 4, 5, 6, 7), sacc[0]); sacc[1] = MFMA32(ka_, __builtin_shufflevector(bl, bh, 0, 1, 2, 3, 4, 5, 6, 7), sacc[1]); } while (0)
#define CH_UPDATE(hs_) do { const int sl3_ = (hs_) % 3; \
            const unsigned aKb = (unsigned)(uintptr_t)(bufK + sl3_ * KSLOT + aKoff), aV0b = (unsigned)(uintptr_t)(bufV + sl3_ * VSLOT + aV0off), aV1b = (unsigned)(uintptr_t)(bufV + sl3_ * VSLOT + aV1off); \
            s16x4 k0l, k0h, a0l, a0h, b0l, b0h, k1l, k1h, a1l, a1h, b1l, b1h; \
            CH_RDK(0, k0l, k0h, a0l, a0h, b0l, b0h); CH_RDK(1, k1l, k1h, a1l, a1h, b1l, b1h); \
            LGKM_WAIT6(6, k0l, k0h, a0l, a0h, b0l, b0h); CH_MM(k0l, k0h, a0l, a0h, b0l, b0h); \
            CH_RDK(2, k0l, k0h, a0l, a0h, b0l, b0h); \
            LGKM_WAIT6(6, k1l, k1h, a1l, a1h, b1l, b1h); CH_MM(k1l, k1h, a1l, a1h, b1l, b1h); \
            CH_RDK(3, k1l, k1h, a1l, a1h, b1l, b1h); \
            LGKM_WAIT6(6, k0l, k0h, a0l, a0h, b0l, b0h); CH_MM(k0l, k0h, a0l, a0h, b0l, b0h); \
            LGKM_WAIT6(0, k1l, k1h, a1l, a1h, b1l, b1h); CH_MM(k1l, k1h, a1l, a1h, b1l, b1h); } while (0)
        __syncthreads();
        for (int i = F.tid; i < 64 * PQ / 16; i += NTHREADS) *(LAS u32x4*)(ST + i * 16) = (u32x4){0u, 0u, 0u, 0u};
        {
            const int n = dir ? 63 : 0; const bf16_t* base = PROJ + ((size_t)b * SEQ + (size_t)n * 128) * RET_IN;
#pragma unroll
            for (int ks = 0; ks < 8; ++ks) GLD128(qa[ks], base + qoff + 32 * ks);
            CH_LOADV(0, vA); CH_ISSUE(0);
            asm volatile("s_waitcnt vmcnt(4)" : "+v"(vA) :: "memory");
            CH_WRITEV(0, vA); CH_LOADV(1, vB); CH_LOADV(2, vA); CH_ISSUE(1);
        }
        asm volatile("s_waitcnt vmcnt(4)" : "+v"(vB) :: "memory");
        asm volatile("" : "+v"(vA));
#pragma unroll
        for (int ks = 0; ks < 8; ++ks) asm volatile("" : "+v"(qa[ks]));
        __syncthreads();
#define CHAIN_STEP(step_, QC, QN) do { \
            const int n = dir ? 63 - (step_) : (step_); \
            const size_t tok0 = (size_t)b * SEQ + (size_t)n * 128; \
              \
            CH_WRITEV(2 * (step_) + 1, vB); \
            if ((step_) < 63) { CH_LOADV(2 * (step_) + 3, vB); CH_ISSUE(2 * (step_) + 2); } \
            {     \
                const int nn = ((step_) < 63) ? (dir ? n - 1 : n + 1) : n; const bf16_t* nbase = PROJ + ((size_t)b * SEQ + (size_t)nn * 128) * RET_IN; \
                _Pragma("unroll") for (int ks = 0; ks < 8; ++ks) GLD128(QN[ks], nbase + qoff + 32 * ks); \
                f32x4 acc[4]; \
                _Pragma("unroll") for (int e4 = 0; e4 < 4; ++e4) acc[e4] = (f32x4){0.f, 0.f, 0.f, 0.f}; \
                const unsigned stb = (unsigned)(uintptr_t)(ST + n16 * PQ + 16 * g); bf16x8 sf[2][4]; \
                _Pragma("unroll") for (int e4 = 0; e4 < 4; ++e4) RD128(sf[0][e4], stb, (16 * e4) * PQ); \
                _Pragma("unroll") for (int ks = 0; ks < 8; ++ks) { \
                    if (ks < 7) { _Pragma("unroll") for (int e4 = 0; e4 < 4; ++e4) RD128(sf[(ks + 1) & 1][e4], stb, (16 * e4) * PQ + 64 * (ks + 1)); \
                                  LGKM_WAIT4(4, sf[ks & 1][0], sf[ks & 1][1], sf[ks & 1][2], sf[ks & 1][3]); } \
                    else { LGKM_WAIT4(0, sf[ks & 1][0], sf[ks & 1][1], sf[ks & 1][2], sf[ks & 1][3]); } \
                    _Pragma("unroll") for (int e4 = 0; e4 < 4; ++e4) acc[e4] = MFMA16(sf[ks & 1][e4], QC[ks], acc[e4]); } \
                bf16_t* op = CROSS + (tok0 + c16) * 2048 + h * 512 + sl * 64 + 4 * g; \
                _Pragma("unroll") for (int e4 = 0; e4 < 4; ++e4) *(u32x2*)(op + 16 * e4) = pack4(acc[e4][0] * xi, acc[e4][1] * xi, acc[e4][2] * xi, acc[e4][3] * xi); \
            } \
            _Pragma("unroll") for (int i = 0; i < 16; ++i) { sacc[0][i] *= dec; sacc[1][i] *= dec; } \
            CH_UPDATE(2 * (step_)); \
              \
            if ((step_) < 63) asm volatile("s_waitcnt vmcnt(17)" : "+v"(vA) :: "memory"); else asm volatile("s_waitcnt vmcnt(12)" : "+v"(vA) :: "memory");        \
            RAW_BARRIER();         \
              \
            if ((step_) < 63) { CH_WRITEV(2 * (step_) + 2, vA); if ((step_) < 62) CH_LOADV(2 * (step_) + 4, vA); CH_ISSUE(2 * (step_) + 3); } \
            CH_UPDATE(2 * (step_) + 1); \
            _Pragma("unroll") for (int e2 = 0; e2 < 2; ++e2) \
                _Pragma("unroll") for (int g4 = 0; g4 < 4; ++g4) *(LAS u32x2*)(ST + (32 * e2 + l32) * PQ + (32 * w + 8 * g4 + 4 * hh) * 2) = pack4(sacc[e2][4 * g4], sacc[e2][4 * g4 + 1], sacc[e2][4 * g4 + 2], sacc[e2][4 * g4 + 3]); \
              \
            if ((step_) < 63) asm volatile("s_waitcnt vmcnt(5)" : "+v"(vB) :: "memory"); else asm volatile("s_waitcnt vmcnt(0)" : "+v"(vB) :: "memory");        \
            _Pragma("unroll") for (int ks = 0; ks < 8; ++ks) asm volatile("" : "+v"(QN[ks])); \
            RAW_BARRIER();         \
        } while (0)
        for (int step = 0; step < 64; step += 2) { CHAIN_STEP(step, qa, qb); CHAIN_STEP(step + 1, qb, qa); }
#undef CHAIN_STEP
#undef CH_ISSUE
#undef CH_UPDATE
#undef CH_RDK
#undef CH_MM
#undef CH_WRITEV
#undef CH_LOADV
    }
}
__device__ __forceinline__ void ret_intra_phase(const Frame& F0, KP p, int j) {
    const Frame F = relaunder(F0);
    constexpr int PQ = 528, PP = 272, PX = 1040;
    LAS unsigned char* R0 = F.lds; LAS unsigned char* R1 = F.lds + 128 * PQ; LAS unsigned char* X = F.lds; LAS float* red = (LAS float*)(F.lds + 128 * PX);
    bf16_t* PROJ = (bf16_t*)(p.ws + WS_PROJ);
    const bf16_t* CF = (const bf16_t*)(p.ws + WS_CROSSF); const bf16_t* CB = (const bf16_t*)(p.ws + WS_CROSSB);
    const int lane0 = F.lane, w = F.wave;
    for (int unit = F.vcu; unit < 1024; unit += F.G) {
        int lane = lane0; asm volatile("" : "+v"(lane));
        const int l32 = lane & 31, hh = lane >> 5, blk = (lane >> 4) & 1, q4 = (lane & 15) >> 2, p4 = lane & 3;
        const int b = unit >> 8, h = (unit >> 6) & 3, n = unit & 63;
        const float lgf = log2_gamma(p.ret_decay + (size_t)j * 8 + h), lgb = log2_gamma(p.ret_decay + (size_t)j * 8 + 4 + h);
        const size_t tok0 = (size_t)b * SEQ + (size_t)n * 128;
        const int tr0 = F.tid >> 5, tc = F.tid & 31;
        const bf16_t* vsrc = PROJ + (tok0 + tr0) * RET_IN + 2048 + h * 512 + tc * 8;
        __syncthreads();
        load_tile<128, 256>(R0, PQ, PROJ + tok0 * RET_IN + h * 256, RET_IN, F.tid);
        load_tile<128, 256>(R1, PQ, PROJ + tok0 * RET_IN + 1024 + h * 256, RET_IN, F.tid);
        u32x4 vreg[8];
#pragma unroll
        for (int i = 0; i < 8; ++i) vreg[i] = *(const u32x4*)(vsrc + (size_t)(16 * i) * RET_IN);
        __syncthreads();
        {
            const int mt = w >> 1;
            f32x16 pacc[2]; pacc[0] = zero16(); pacc[1] = zero16();
#pragma unroll
            for (int ks = 0; ks < 16; ++ks) {
                const bf16x8 a = *(const LAS bf16x8*)(R1 + (32 * mt + l32) * PQ + (16 * ks + 8 * hh) * 2);
#pragma unroll
                for (int ci = 0; ci < 2; ++ci) { const int ct = 2 * (w & 1) + ci;
                    const bf16x8 bq = *(const LAS bf16x8*)(R0 + (32 * ct + l32) * PQ + (16 * ks + 8 * hh) * 2);
                    pacc[ci] = MFMA32(a, bq, pacc[ci]); }
            }
#pragma unroll
            for (int ci = 0; ci < 2; ++ci) { const int c = 32 * (2 * (w & 1) + ci) + l32;
#pragma unroll
                for (int i = 0; i < 16; ++i) { const int m = 32 * mt + (i & 3) + 8 * (i >> 2) + 4 * hh; const int dl = c - m;
                    pacc[ci][i] *= (dl >= 0) ? fast_exp2(lgf * (float)dl) : fast_exp2(lgb * (float)(-dl)); } }
            __syncthreads();
#pragma unroll
            for (int ci = 0; ci < 2; ++ci) { const int c = 32 * (2 * (w & 1) + ci) + l32;
#pragma unroll
                for (int g4 = 0; g4 < 4; ++g4) *(LAS u32x2*)(R0 + c * PP + (32 * mt + 8 * g4 + 4 * hh) * 2) = pack4(pacc[ci][4 * g4], pacc[ci][4 * g4 + 1], pacc[ci][4 * g4 + 2], pacc[ci][4 * g4 + 3]); }
        }
        f32x16 oacc[2][4];
#pragma unroll
        for (int hf = 0; hf < 2; ++hf)
#pragma unroll
            for (int e = 0; e < 4; ++e) oacc[hf][e] = zero16();
        const int ct = w & 3, eg = w >> 2;
#pragma unroll
        for (int hf = 0; hf < 2; ++hf) {
            if (hf == 1) __syncthreads();
#pragma unroll
            for (int i = 0; i < 8; ++i) *(LAS u32x4*)(R1 + (tr0 + 16 * i) * PQ + tc * 16) = vreg[i];
            if (hf == 0) {
#pragma unroll
                for (int i = 0; i < 8; ++i) vreg[i] = *(const u32x4*)(vsrc + 256 + (size_t)(16 * i) * RET_IN);
            }
            __syncthreads();
            const LAS unsigned char* aV = R1 + (8 * hh + q4) * PQ + 32 * blk + 8 * p4;
#pragma unroll
            for (int ks = 0; ks < 8; ++ks) {
                const bf16x8 pb = *(const LAS bf16x8*)(R0 + (32 * ct + l32) * PP + (16 * ks + 8 * hh) * 2);
#pragma unroll
                for (int e = 0; e < 4; ++e) { const int et = 4 * eg + e;
                    const bf16x8 va = tr_read2(aV + (16 * ks) * PQ + 64 * et, aV + (16 * ks + 4) * PQ + 64 * et);
                    oacc[hf][e] = MFMA32(va, pb, oacc[hf][e]); }
            }
        }
        __syncthreads();
        {
            const int xr0 = F.tid >> 6, xc = F.tid & 63;
            const bf16_t* fp = CF + (tok0 + xr0) * 2048 + h * 512 + xc * 8; const bf16_t* bp = CB + (tok0 + xr0) * 2048 + h * 512 + xc * 8;
#pragma unroll
            for (int qtr = 0; qtr < 4; ++qtr) {
                u32x4 fv[4], bv[4];
#pragma unroll
                for (int i = 0; i < 4; ++i) { fv[i] = *(const u32x4*)(fp + (size_t)(8 * (4 * qtr + i)) * 2048); bv[i] = *(const u32x4*)(bp + (size_t)(8 * (4 * qtr + i)) * 2048); }
#pragma unroll
                for (int i = 0; i < 4; ++i) { u32x4 o;
                    o.x = cvt_pk_bf16(bf_lo(fv[i].x) + bf_lo(bv[i].x), bf_hi(fv[i].x) + bf_hi(bv[i].x)); o.y = cvt_pk_bf16(bf_lo(fv[i].y) + bf_lo(bv[i].y), bf_hi(fv[i].y) + bf_hi(bv[i].y));
                    o.z = cvt_pk_bf16(bf_lo(fv[i].z) + bf_lo(bv[i].z), bf_hi(fv[i].z) + bf_hi(bv[i].z)); o.w = cvt_pk_bf16(bf_lo(fv[i].w) + bf_lo(bv[i].w), bf_hi(fv[i].w) + bf_hi(bv[i].w));
                    *(LAS u32x4*)(X + (xr0 + 8 * (4 * qtr + i)) * PX + xc * 16) = o; }
                asm volatile("" ::: "memory");
            }
        }
        __syncthreads();
        LAS unsigned char* xrow = X + (32 * ct + l32) * PX;
        float ss = 0.f;
#pragma unroll
        for (int hf = 0; hf < 2; ++hf)
#pragma unroll
            for (int e = 0; e < 4; ++e)
#pragma unroll
                for (int g4 = 0; g4 < 4; ++g4) { const int e0 = hf * 256 + 32 * (4 * eg + e) + 8 * g4 + 4 * hh;
                    const u32x2 cx = *(const LAS u32x2*)(xrow + e0 * 2);
                    const float o0 = oacc[hf][e][4 * g4] + bf_lo(cx.x), o1 = oacc[hf][e][4 * g4 + 1] + bf_hi(cx.x), o2 = oacc[hf][e][4 * g4 + 2] + bf_lo(cx.y), o3 = oacc[hf][e][4 * g4 + 3] + bf_hi(cx.y);
                    ss += (o0 * o0 + o1 * o1) + (o2 * o2 + o3 * o3);
                    *(LAS u32x2*)(xrow + e0 * 2) = pack4(o0, o1, o2, o3); }
        ss += __shfl_xor(ss, 32);
        if (hh == 0) red[(32 * ct + l32) * 2 + eg] = ss;
        __syncthreads();
        {
            const int xr0 = F.tid >> 6, xc = F.tid & 63;
            bf16_t* gp = PROJ + (tok0 + xr0) * RET_IN + 4096 + h * 512 + xc * 8;
#pragma unroll
            for (int half = 0; half < 2; ++half) {
                u32x4 gv[8];
#pragma unroll
                for (int i = 0; i < 8; ++i) gv[i] = *(const u32x4*)(gp + (size_t)(8 * (8 * half + i)) * RET_IN);
#pragma unroll
                for (int i = 0; i < 8; ++i) { const int r = xr0 + 8 * (8 * half + i);
                    const float rstd = 1.0f / sqrtf((red[r * 2] + red[r * 2 + 1]) * (1.0f / 512.0f) + EPS);
                    const u32x4 ov = *(const LAS u32x4*)(X + r * PX + xc * 16); u32x4 o;
                    o.x = cvt_pk_bf16(bf_lo(ov.x) * rstd * silu_f(bf_lo(gv[i].x)), bf_hi(ov.x) * rstd * silu_f(bf_hi(gv[i].x))); o.y = cvt_pk_bf16(bf_lo(ov.y) * rstd * silu_f(bf_lo(gv[i].y)), bf_hi(ov.y) * rstd * silu_f(bf_hi(gv[i].y)));
                    o.z = cvt_pk_bf16(bf_lo(ov.z) * rstd * silu_f(bf_lo(gv[i].z)), bf_hi(ov.z) * rstd * silu_f(bf_hi(gv[i].z))); o.w = cvt_pk_bf16(bf_lo(ov.w) * rstd * silu_f(bf_lo(gv[i].w)), bf_hi(ov.w) * rstd * silu_f(bf_hi(gv[i].w)));
                    *(u32x4*)(gp + (size_t)(8 * (8 * half + i)) * RET_IN) = o; }
            }
        }
    }
}

__device__ __forceinline__ void gm_spatial_phase(const Frame& F0, KP p) {
    const Frame F = relaunder(F0);
    constexpr int PW = 272, PVV = 528;
    LAS unsigned char* Wp = F.lds; LAS unsigned char* Vt = F.lds + 128 * PW;
    LAS float* mu = (LAS float*)(F.lds + 128 * PW + 128 * PVV); LAS float* rs = mu + 128; LAS float* corr = rs + 128; LAS float* rsw = corr + 128;
    bf16_t* PROJ = (bf16_t*)(p.ws + WS_PROJ);
    const float* stat = (const float*)(p.ws + WS_GMSTAT);
    const int lane = F.lane, w = F.wave, l32 = lane & 31, hh = lane >> 5, blk = (lane >> 4) & 1, q4 = (lane & 15) >> 2, p4 = lane & 3;
    const int tr0 = F.tid >> 5, tc = F.tid & 31;
    for (int item = F.vcu; item < NB * 64; item += F.G) {
        const int b = item >> 6, n = item & 63;
        const size_t tok0 = (size_t)b * SEQ + (size_t)n * 128;
        const bf16_t* vsrc = PROJ + (tok0 + tr0) * GM_FFN + GM_HALF + tc * 8;
        bf16_t* usrc = PROJ + (tok0 + tr0) * GM_FFN + tc * 8;
        __syncthreads();
        if (F.tid < 128) { float s1 = 0.f, s2 = 0.f;
            for (int q = 0; q < 48; ++q) { const f32x2 v = *(const f32x2*)(stat + ((size_t)q * T + tok0 + F.tid) * 2); s1 += v.x; s2 += v.y; }
            const float m = s1 * (1.0f / GM_HALF), var = fmaxf(s2 * (1.0f / GM_HALF) - m * m, 0.f);
            mu[F.tid] = m; rs[F.tid] = 1.0f / sqrtf(var + EPS); }
        u32x4 vreg[8];
#pragma unroll
        for (int i = 0; i < 8; ++i) vreg[i] = *(const u32x4*)(vsrc + (size_t)(16 * i) * GM_FFN);
        __syncthreads();
        for (int un = 0; un < 12; ++un) {
            const int g = un / 3, th = un - 3 * g, cbase = g * 768 + th * 256;
            if (th == 0) {
                const int t = F.tid >> 2, qd = F.tid & 3; const float* wrow = p.gm_w_s + ((size_t)g * 128 + t) * 128 + 32 * qd;
                float cs = 0.f, rw = 0.f;
#pragma unroll
                for (int i = 0; i < 8; ++i) { const f32x4 wv = *(const f32x4*)(wrow + 4 * i); const int sidx = 32 * qd + 4 * i;
                    const float a0 = wv.x * rs[sidx], a1 = wv.y * rs[sidx + 1], a2 = wv.z * rs[sidx + 2], a3 = wv.w * rs[sidx + 3];
                    cs += (a0 * mu[sidx] + a1 * mu[sidx + 1]) + (a2 * mu[sidx + 2] + a3 * mu[sidx + 3]); rw += (wv.x + wv.y) + (wv.z + wv.w);
                    *(LAS u32x2*)(Wp + t * PW + sidx * 2) = pack4(a0, a1, a2, a3); }
                cs += __shfl_xor(cs, 1); cs += __shfl_xor(cs, 2); rw += __shfl_xor(rw, 1); rw += __shfl_xor(rw, 2);
                if (qd == 0) { corr[t] = cs; rsw[t] = rw; }
            }
#pragma unroll
            for (int i = 0; i < 8; ++i) *(LAS u32x4*)(Vt + (tr0 + 16 * i) * PVV + tc * 16) = vreg[i];
            __syncthreads();
            if (un < 11) { const int g2 = (un + 1) / 3, th2 = (un + 1) - 3 * g2; const bf16_t* vs2 = vsrc + g2 * 768 + th2 * 256;
#pragma unroll
                for (int i = 0; i < 8; ++i) vreg[i] = *(const u32x4*)(vs2 + (size_t)(16 * i) * GM_FFN); }
            const int tt = w & 3, cg = w >> 2;
            f32x16 acc[4];
#pragma unroll
            for (int e = 0; e < 4; ++e) acc[e] = zero16();
            const LAS unsigned char* aV = Vt + (8 * hh + q4) * PVV + 32 * blk + 8 * p4;
#pragma unroll
            for (int ks = 0; ks < 8; ++ks) {
                const bf16x8 wb = *(const LAS bf16x8*)(Wp + (32 * tt + l32) * PW + (16 * ks + 8 * hh) * 2);
#pragma unroll
                for (int e = 0; e < 4; ++e) { const int ct = 4 * cg + e;
                    const bf16x8 va = tr_read2(aV + (16 * ks) * PVV + 64 * ct, aV + (16 * ks + 4) * PVV + 64 * ct);
                    acc[e] = MFMA32(va, wb, acc[e]); }
            }
            __syncthreads();
            const int t = 32 * tt + l32; const float co = corr[t], rwt = rsw[t], bs = p.gm_b_s[g * 128 + t];
#pragma unroll
            for (int e = 0; e < 4; ++e)
#pragma unroll
                for (int g4 = 0; g4 < 4; ++g4) { const int cl = 32 * (4 * cg + e) + 8 * g4 + 4 * hh, c0 = cbase + cl;
                    const f32x4 lg = *(const f32x4*)(p.gm_ln_g + c0), lb = *(const f32x4*)(p.gm_ln_b + c0);
                    *(LAS u32x2*)(Vt + t * PVV + cl * 2) = pack4(lg.x * (acc[e][4 * g4] - co) + lb.x * rwt + bs, lg.y * (acc[e][4 * g4 + 1] - co) + lb.y * rwt + bs,
                                                                 lg.z * (acc[e][4 * g4 + 2] - co) + lb.z * rwt + bs, lg.w * (acc[e][4 * g4 + 3] - co) + lb.w * rwt + bs); }
            __syncthreads();
            {
                bf16_t* up = usrc + cbase; u32x4 uv[8];
#pragma unroll
                for (int i = 0; i < 8; ++i) uv[i] = *(const u32x4*)(up + (size_t)(16 * i) * GM_FFN);
#pragma unroll
                for (int i = 0; i < 8; ++i) { const u32x4 mv = *(const LAS u32x4*)(Vt + (tr0 + 16 * i) * PVV + tc * 16); u32x4 o;
                    o.x = cvt_pk_bf16(bf_lo(uv[i].x) * bf_lo(mv.x), bf_hi(uv[i].x) * bf_hi(mv.x)); o.y = cvt_pk_bf16(bf_lo(uv[i].y) * bf_lo(mv.y), bf_hi(uv[i].y) * bf_hi(mv.y));
                    o.z = cvt_pk_bf16(bf_lo(uv[i].z) * bf_lo(mv.z), bf_hi(uv[i].z) * bf_hi(mv.z)); o.w = cvt_pk_bf16(bf_lo(uv[i].w) * bf_lo(mv.w), bf_hi(uv[i].w) * bf_hi(mv.w));
                    *(u32x4*)(up + (size_t)(16 * i) * GM_FFN) = o; }
            }
            __syncthreads();
        }
    }
}

__device__ __forceinline__ void na_attn_phase(const Frame& F0, KP p) {
    const Frame F = relaunder(F0);
    constexpr int KS = 80, RING = 12, ROWB = 64 * KS;
    LAS unsigned char* Kl = F.lds; LAS unsigned char* Vl = F.lds + RING * ROWB; LAS float* rpbl = (LAS float*)(F.lds + 2 * RING * ROWB);
    bf16_t* PROJ = (bf16_t*)(p.ws + WS_PROJ);
    const int lane = F.lane, w = F.wave, n16 = lane & 15, g = lane >> 4, q4 = (lane & 15) >> 2, p4 = lane & 3;
    const int qrow = w >> 2, qb = w & 3;
    const int kc0 = qb == 0 ? 0 : qb == 1 ? 8 : qb == 2 ? 24 : 32;
    const int c = 16 * qb + n16, cstart = min(max(c - 8, 0), 48);
    for (int item = F.vcu; item < NB * 32 * 2; item += F.G) {
        const int half = item & 1, h = (item >> 1) & 31, b = item >> 6;
        const bf16_t* kvbase = PROJ + (size_t)b * SEQ * 3072 + h * 32;
        __syncthreads();
        for (int i = F.tid; i < 15 * 31; i += NTHREADS) rpbl[i] = p.na_rpb[(size_t)h * 465 + i];
        {
            const int rp = 32 * half, lo = min(max(2 * rp - 4, 0), 120), hi = min(max(2 * rp + 1 - 4, 0), 120) + 7, nrow = hi - lo + 1;
            for (int i = F.tid; i < nrow * 256; i += NTHREADS) { const int key = i >> 2, ch = i & 3, rr = lo + (key >> 6), kcol = key & 63;
                const bf16_t* src = kvbase + ((size_t)rr * 64 + kcol) * 3072 + ch * 8; const int off = ((rr % RING) * 64 + kcol) * KS + ch * 16;
                *(LAS u32x4*)(Kl + off) = *(const u32x4*)(src + 1024); *(LAS u32x4*)(Vl + off) = *(const u32x4*)(src + 2048); }
        }
#define NA_HI(k) (min(max(2 * (32 * half + (k)) + 1 - 4, 0), 120) + 7)
#define NA_LOAD(k, KP_, VP_, PO_) do { PO_ = -1; if ((k) < 32) { const int lh_ = NA_HI((k) - 1), nnew_ = NA_HI(k) - lh_; \
            if (F.tid < nnew_ * 256) { const int key = F.tid >> 2, ch = F.tid & 3, rr = lh_ + 1 + (key >> 6), kcol = key & 63; \
                const bf16_t* src = kvbase + ((size_t)rr * 64 + kcol) * 3072 + ch * 8; PO_ = ((rr % RING) * 64 + kcol) * KS + ch * 16; \
                KP_ = *(const u32x4*)(src + 1024); VP_ = *(const u32x4*)(src + 2048); } } } while (0)
#define NA_QLOAD(k, Q_) do { if ((k) < 32) Q_ = *(const bf16x8*)(PROJ + ((size_t)b * SEQ + (2 * (32 * half + (k)) + qrow) * 64 + c) * 3072 + h * 32 + 8 * g); } while (0)
        u32x4 kA, vA, kB, vB; int pA = -1, pB = -1; bf16x8 qA, qB;
        NA_QLOAD(0, qA); NA_QLOAD(1, qB);
        NA_LOAD(1, kB, vB, pB);
        __syncthreads();
        f32x4 bt[16]; int tab_dr = -1000;
#define NA_UNIT(u, KLD, VLD, PLD, KWR, VWR, PWR, QC) do { \
            const int rp = 32 * half + (u), r = 2 * rp + qrow, r0 = min(max(r - 4, 0), 120); \
            const size_t tokq = (size_t)b * SEQ + r * 64 + c; \
            NA_LOAD((u) + 2, KLD, VLD, PLD); \
            const int s0 = r0 % RING; \
            f32x4 sacc[16]; \
            _Pragma("unroll") for (int tau = 0; tau < 16; ++tau) { const int kr = tau >> 1, hf = tau & 1; int slot = s0 + kr; slot = slot >= RING ? slot - RING : slot; \
                const bf16x8 kf = *(const LAS bf16x8*)(Kl + (slot * 64 + kc0 + 16 * hf + n16) * KS + 16 * g); \
                const f32x4 z4 = {0.f, 0.f, 0.f, 0.f}; sacc[tau] = MFMA16(kf, QC, z4); } \
            NA_QLOAD((u) + 2, QC); \
            if (r0 - r != tab_dr) { tab_dr = r0 - r; \
                _Pragma("unroll") for (int tau = 0; tau < 16; ++tau) { const int kr = tau >> 1, hf = tau & 1; const int ro = tab_dr + kr + 7; \
                    _Pragma("unroll") for (int i = 0; i < 4; ++i) { const int kcol = kc0 + 16 * hf + 4 * g + i; const bool ok = (kcol >= cstart) && (kcol < cstart + 16); \
                        const int co = min(max(kcol - c + 15, 0), 30); \
                        bt[tau][i] = ok ? rpbl[ro * 31 + co] * LOG2E : -3.0e38f; } } } \
            float mx = -3.0e38f; \
            _Pragma("unroll") for (int tau = 0; tau < 16; ++tau) { sacc[tau] = sacc[tau] + bt[tau]; mx = fmaxf(fmaxf(mx, fmaxf(sacc[tau][0], sacc[tau][1])), fmaxf(sacc[tau][2], sacc[tau][3])); } \
            mx = fmaxf(mx, __shfl_xor(mx, 16)); mx = fmaxf(mx, __shfl_xor(mx, 32)); \
            float sum = 0.f; \
            _Pragma("unroll") for (int tau = 0; tau < 16; ++tau) \
                _Pragma("unroll") for (int i = 0; i < 4; ++i) { const float e = fast_exp2(sacc[tau][i] - mx); sacc[tau][i] = e; sum += e; } \
            sum += __shfl_xor(sum, 16); sum += __shfl_xor(sum, 32); \
            const float inv = 1.0f / sum; \
            f32x4 oacc[2]; oacc[0] = (f32x4){0.f, 0.f, 0.f, 0.f}; oacc[1] = (f32x4){0.f, 0.f, 0.f, 0.f}; \
            _Pragma("unroll") for (int kr = 0; kr < 8; ++kr) { \
                u32x4 pw; pw.x = cvt_pk_bf16(sacc[2 * kr][0], sacc[2 * kr][1]); pw.y = cvt_pk_bf16(sacc[2 * kr][2], sacc[2 * kr][3]); pw.z = cvt_pk_bf16(sacc[2 * kr + 1][0], sacc[2 * kr + 1][1]); pw.w = cvt_pk_bf16(sacc[2 * kr + 1][2], sacc[2 * kr + 1][3]); \
                const bf16x8 pf = __builtin_bit_cast(bf16x8, pw); \
                int slot = s0 + kr; slot = slot >= RING ? slot - RING : slot; \
                const LAS unsigned char* a0 = Vl + (slot * 64 + kc0 + 4 * g + q4) * KS + 8 * p4; const LAS unsigned char* a1 = a0 + 16 * KS; \
                _Pragma("unroll") for (int md = 0; md < 2; ++md) { const bf16x8 vf = tr_read2(a0 + 32 * md, a1 + 32 * md); \
                    oacc[md] = MFMA16(vf, pf, oacc[md]); } \
            } \
            bf16_t* op = PROJ + tokq * 3072 + h * 32 + 4 * g; \
            *(u32x2*)op = pack4(oacc[0][0] * inv, oacc[0][1] * inv, oacc[0][2] * inv, oacc[0][3] * inv); \
            *(u32x2*)(op + 16) = pack4(oacc[1][0] * inv, oacc[1][1] * inv, oacc[1][2] * inv, oacc[1][3] * inv); \
            if (PWR >= 0) { *(LAS u32x4*)(Kl + PWR) = KWR; *(LAS u32x4*)(Vl + PWR) = VWR; } \
            __syncthreads(); } while (0)
        for (int u = 0; u < 32; u += 2) {
            NA_UNIT(u, kA, vA, pA, kB, vB, pB, qA);
            NA_UNIT(u + 1, kB, vB, pB, kA, vA, pA, qB);
        }
#undef NA_UNIT
#undef NA_QLOAD
#undef NA_LOAD
#undef NA_HI
    }
}

#ifndef PHASE_MASK
#define PHASE_MASK 0xFFFFFFFFu
#endif
#define PH(k) ((PHASE_MASK >> (k)) & 1u)
#ifndef DBG_BARWAIT_CLS
#define DBG_BARWAIT_CLS -1
#endif
#define BAR(cls) do { TCK(cls); xcd_barrier_steal(bar); if ((cls) == DBG_BARWAIT_CLS || DBG_BARWAIT_CLS == -1) { TCK(13); } else { TCK(31); } } while (0)

__device__ __forceinline__ void moe_layer(const Frame& F, KP p, const XcdBarrier& bar, int layer, float* x) {
    if (PH(0)) moe_route_phase(F, p, layer, x);
    TCK(8); conv_drain(F, p, layer == 0 ? CQ_E_MOE0 : layer == 1 ? CQ_E_MOE1 : layer == 2 ? CQ_E_MOE2 : CQ_E_MOE3);
    BAR(14);
    const unsigned* cnt = (const unsigned*)(p.ws + WS_CTL) + CW_MOECNT + layer * 32;
    LAS int* tab = (LAS int*)(F.lds + pg8::STAGE_BYTES);
    LAS float* gl = (LAS float*)(F.lds + pg8::STAGE_BYTES + 4096);
    const int NT = moe_tile_table(F, cnt, tab, (const float*)(p.ws + WS_MOD) + (size_t)layer * NB * 6144 + MOD_G2, gl);
    const float* tok_wa = (const float*)(p.ws + WS_TOK); const float* tok_wb = tok_wa + T;
    {
        MoeSched S; S.G = F.G; S.c = F.vcu; S.NP = 8; S.NT = NT; S.tile_cls = tab; S.Abase = (const char*)(p.ws + WS_H2); S.rowtok = (const int*)(p.ws + WS_ROWTOK); S.cnt = cnt; S.done = nullptr; S.tmo = nullptr;
        S.wmat = (size_t)1024 * 1024 * 2; S.bntile = (size_t)256 * 1024 * 2; S.Wbase = (const char*)(p.ws + WS_W_MOE_GU) + (size_t)layer * 16 * S.wmat;
        EpiMoeGU E{(bf16_t*)(p.ws + WS_HID), tok_wa, tok_wb, (unsigned*)(p.ws + WS_CTL) + CW_MOEDONE + layer * 256, (bf16_t*)(p.ws + WS_ROW)};
        if (PH(2)) pg8::gemm_phase<EpiMoeGU, MoeSched, true, 0, true>(F.lds, 1024, 1024, 1024, S, E);
    }
    TCK(10);
    {
        MoeSched S; S.G = F.G; S.c = F.vcu; S.NP = 4; S.NT = NT; S.tile_cls = tab; S.Abase = (const char*)(p.ws + WS_HID); S.rowtok = (const int*)(p.ws + WS_ROWTOK); S.cnt = cnt; S.done = (unsigned*)(p.ws + WS_CTL) + CW_MOEDONE + layer * 256; S.tmo = (unsigned*)(p.ws + WS_CTL) + CW_BAR + XB_TMO;
        S.wmat = (size_t)1024 * 512 * 2; S.bntile = (size_t)256 * 512 * 2; S.Wbase = (const char*)(p.ws + WS_W_MOE_DN) + (size_t)layer * 16 * S.wmat;
        EpiMoeDown E{x, gl, (float*)(p.ws + WS_ROW + 65536)};
        if (PH(3)) pg8::gemm_phase<EpiMoeDown, MoeSched, false, 8, true>(F.lds, 1024, 1024, 512, S, E);
    }
    BAR(11);
}
template <class Epi>
__device__ __forceinline__ void dense_gemm(const Frame& F, int N, int K, const bf16_t* A, int lda, const bf16_t* Bt, int ldb, const Epi& E) {
    pg8::DenseOrder S; S.init(T, N, F.G, (int)blockIdx.x, A, (size_t)lda, Bt, (size_t)ldb);
    pg8::gemm_phase<Epi, pg8::DenseOrder, true, 0>(F.lds, K, lda, ldb, S, E);
}
__device__ __forceinline__ void retention_layer(const Frame& F, KP p, const XcdBarrier& bar, int layer, int j, const float* xin, float* xout) {
    const float* modl = (const float*)(p.ws + WS_MOD) + (size_t)layer * NB * 6144;
    bf16_t* H = (bf16_t*)(p.ws + WS_H); bf16_t* PROJ = (bf16_t*)(p.ws + WS_PROJ);
    if (PH(4)) norm_phase(F, xin, p.norm_g + (size_t)(layer * 2) * D, modl, MOD_SH1, MOD_SC1, H);
    TCK(1); conv_drain(F, p, j == 1 ? CQ_E_RET1 : CQ_E_RET0);
    BAR(14);
    if (PH(5)) { EpiRetIn E{PROJ}; dense_gemm(F, RET_IN, D, H, D, (const bf16_t*)(p.ws + WS_W_RET_IN) + (size_t)j * RET_IN * D, D, E); }
    BAR(2);
    if (PH(6)) ret_chain_phase(F, p, j);
    BAR(3);
    if (PH(7)) ret_intra_phase(F, p, j);
    BAR(4);
    if (PH(8)) { EpiResid E{xin, xout, modl + MOD_G1}; dense_gemm(F, D, 2048, PROJ + 4096, RET_IN, (const bf16_t*)(p.ws + WS_W_RET_OUT) + (size_t)j * D * 2048, 2048, E); }
    BAR(7);
}

__global__ void __launch_bounds__(NTHREADS, 2) fwd_kernel(Params p_by_value) {
    (void)p_by_value;
#define p (*kparams())
    extern __shared__ __attribute__((aligned(16))) unsigned char lds_raw[];
    Frame F;
    F.lds = (LAS unsigned char*)lds_raw;
    F.tid = 0; F.lane = 0; F.wave = 0;
    F.G = gridDim.x; { const int bx = blockIdx.x; F.vcu = (F.G % 8 == 0) ? (bx % 8) * (F.G / 8) + bx / 8 : bx; }
    volatile LAS unsigned* MISC = (volatile LAS unsigned*)(F.lds + MISC_OFF);
    if (threadIdx.x < 64) MISC[threadIdx.x] = 0u;
    __syncthreads();
    XcdBarrier bar = xcd_barrier_post((unsigned*)(p.ws + WS_CTL) + CW_BAR, MISC + 8);
    xcd_census(bar);
#ifdef DBG_AMP_MASK
    if (threadIdx.x == 0) ((volatile LAS unsigned long long*)((LAS unsigned char*)0 + DBG_MISC_OFF + 128))[0] = __builtin_amdgcn_s_memrealtime();
#endif
    float* x = p.out;
    bf16_t* H = (bf16_t*)(p.ws + WS_H); bf16_t* PROJ = (bf16_t*)(p.ws + WS_PROJ);

    if (PH(9)) p0_prologue(F, p);
    BAR(0);

    retention_layer(F, p, bar, 0, 0, p.x, x);
    moe_layer(F, p, bar, 0, x);

    {
        const float* modl = (const float*)(p.ws + WS_MOD) + (size_t)1 * NB * 6144;
        if (PH(4)) norm_phase(F, x, p.norm_g + (size_t)2 * D, modl, MOD_SH1, MOD_SC1, H);
        TCK(1); conv_drain(F, p, CQ_E_GM);
        BAR(14);
        if (PH(10)) { EpiGmIn E{PROJ, (float*)(p.ws + WS_GMSTAT)}; dense_gemm(F, GM_FFN, D, H, D, (const bf16_t*)(p.ws + WS_W_GM_IN), D, E); }
        BAR(2);
        if (PH(11)) gm_spatial_phase(F, p);
        BAR(5);
        if (PH(12)) { EpiResid E{x, x, modl + MOD_G1}; dense_gemm(F, D, GM_HALF, PROJ, GM_FFN, (const bf16_t*)(p.ws + WS_W_GM_OUT), GM_HALF, E); }
        BAR(7);
    }
    moe_layer(F, p, bar, 1, x);

    {
        const float* modl = (const float*)(p.ws + WS_MOD) + (size_t)2 * NB * 6144;
        if (PH(4)) norm_phase(F, x, p.norm_g + (size_t)4 * D, modl, MOD_SH1, MOD_SC1, H);
        TCK(1); conv_drain(F, p, CQ_E_NA);
        BAR(14);
        if (PH(13)) { EpiNaIn E{PROJ}; dense_gemm(F, 3 * D, D, H, D, (const bf16_t*)(p.ws + WS_W_NA_QKV), D, E); }
        BAR(2);
        if (PH(14)) na_attn_phase(F, p);
        BAR(6);
        if (PH(15)) { EpiResid E{x, x, modl + MOD_G1}; dense_gemm(F, D, D, PROJ, 3 * D, (const bf16_t*)(p.ws + WS_W_NA_OUT), D, E); }
        BAR(7);
    }
    moe_layer(F, p, bar, 2, x);

    retention_layer(F, p, bar, 3, 1, x, x);
    moe_layer(F, p, bar, 3, x);

    if (PH(16)) final_phase(F, x, p.final_g);
#ifdef DBG_AMP_MASK
    {
        __syncthreads(); TCK(12); __syncthreads();
        const unsigned long long wait = ((volatile LAS unsigned long long*)((LAS unsigned char*)0 + DBG_MISC_OFF + 128))[1] * (unsigned long long)(DBG_AMP_FACTOR);
        const unsigned long long t0 = __builtin_amdgcn_s_memrealtime();
        while (__builtin_amdgcn_s_memrealtime() - t0 < wait) __builtin_amdgcn_s_sleep(32);
    }
#endif
    if (__hip_atomic_load((unsigned*)(p.ws + WS_CTL) + CW_BAR + XB_TMO, __ATOMIC_RELAXED, __HIP_MEMORY_SCOPE_AGENT) != 0u) {
        __syncthreads();
        const float qn = __builtin_nanf("");
        for (size_t i = (size_t)blockIdx.x * NTHREADS + threadIdx.x; i < (size_t)T * D; i += (size_t)F.G * NTHREADS) x[i] = qn;
    }
#undef p
}

extern "C" void kernel_launch(void* const* d_in, const int* in_sizes, int n_in, void* d_out, int out_size, void* d_ws, size_t ws_size, hipStream_t stream) {
    static int grid = 0;
    if (grid == 0) {
        if (n_in != 22 || out_size != T * D || ws_size < WS_END) { fprintf(stderr, "kernel_launch: unexpected sizes (n_in %d, out %d, ws %zu; need ws >= %zu)\n", n_in, out_size, ws_size, (size_t)WS_END); grid = -1; return; }
        int dev = 0, cus = 0, per_cu = 0;
        if (hipGetDevice(&dev) != hipSuccess || hipDeviceGetAttribute(&cus, hipDeviceAttributeMultiprocessorCount, dev) != hipSuccess) { grid = -1; return; }
        if (hipFuncSetAttribute((const void*)fwd_kernel, hipFuncAttributeMaxDynamicSharedMemorySize, LDS_BYTES) != hipSuccess) { fprintf(stderr, "kernel_launch: hipFuncSetAttribute failed\n"); grid = -1; return; }
        if (hipOccupancyMaxActiveBlocksPerMultiprocessor(&per_cu, (const void*)fwd_kernel, NTHREADS, LDS_BYTES) != hipSuccess || per_cu < 1) fprintf(stderr, "kernel_launch: occupancy query reports %d\n", per_cu);
        (void)hipGetLastError();
        grid = cus;
    }
    if (grid < 0) return;
    if (hipMemsetAsync((char*)d_ws + WS_CTL, 0, CTL_ZERO_BYTES, stream) != hipSuccess) return;
    Params p{};
    const float** pf = (const float**)&p;
    for (int i = 0; i < 22; ++i) pf[i] = (const float*)d_in[i];
    p.out = (float*)d_out; p.ws = (unsigned char*)d_ws;
    hipLaunchKernelGGL(fwd_kernel, dim3(grid), dim3(NTHREADS), LDS_BYTES, stream, p);
}
```
